# Optimizing an MI355X kernel written in HIP

```python
import math
import jax, jax.numpy as jnp
from jax import lax
import numpy as np

D_MODEL = 4096
BATCH = 2
SEQ = 8192
DEPTH = 1

ATTN_HEAD_DIM = 128
ATTN_WIDTH = D_MODEL // 2
ATTN_HEADS = ATTN_WIDTH // ATTN_HEAD_DIM
Q_BLOCK = 128
SSM_GROUP = 16
SSM_WIDTH = D_MODEL // 4
SSM_GROUPS = SSM_WIDTH // SSM_GROUP
SSM_STATE = 64
DT_MIN = 1e-3
DT_MAX = 1e-1
N_BRANCH = 2
OFF_Q = 0
OFF_K = ATTN_WIDTH
OFF_V = 2 * ATTN_WIDTH
OFF_F = 3 * ATTN_WIDTH
OFF_U = OFF_F + ATTN_HEADS
OFF_G = OFF_U + SSM_WIDTH
IN_WIDTH = OFF_G + N_BRANCH * D_MODEL
MEM_LEN = 256
XATTN_HEADS = 4
XATTN_HEAD_DIM = 256
XATTN_WIDTH = XATTN_HEADS * XATTN_HEAD_DIM
D_FF = 4 * D_MODEL
EPS = 1e-6
NEG_INF = -1e30

kernel_name = "hybrid_fox_s5_gated_block"


def rmsnorm(x, g):
    xf = x.astype(jnp.float32)
    r = lax.rsqrt(jnp.mean(xf * xf, axis=-1, keepdims=True) + EPS)
    return (xf * r).astype(x.dtype) * g


def forgetting_attention(q, k, v, log_f):
    bsz, seq, heads, dh = q.shape
    c = jnp.cumsum(log_f, axis=1).transpose(0, 2, 1)
    qh = q.transpose(0, 2, 1, 3)
    kh = k.transpose(0, 2, 1, 3)
    vh = v.transpose(0, 2, 1, 3)
    k_pos = jnp.arange(seq)
    scale = dh ** -0.5

    def block(i):
        start = i * Q_BLOCK
        qb = lax.dynamic_slice_in_dim(qh, start, Q_BLOCK, axis=2)
        cb = lax.dynamic_slice_in_dim(c, start, Q_BLOCK, axis=2)
        s = jnp.einsum('bhqd,bhkd->bhqk', qb, kh).astype(jnp.float32) * scale
        s = s + cb[..., :, None] - c[..., None, :]
        q_pos = start + jnp.arange(Q_BLOCK)
        s = jnp.where(k_pos[None, :] <= q_pos[:, None], s, NEG_INF)
        p = jax.nn.softmax(s, axis=-1).astype(vh.dtype)
        return jnp.einsum('bhqk,bhkd->bhqd', p, vh)

    out = lax.map(block, jnp.arange(seq // Q_BLOCK))
    return out.transpose(1, 0, 3, 2, 4).reshape(bsz, seq, heads * dh)


def _complex_linear_combine(e1, e2):
    a1r, a1i, b1r, b1i = e1
    a2r, a2i, b2r, b2i = e2
    ar = a1r * a2r - a1i * a2i
    ai = a1r * a2i + a1i * a2r
    br = a2r * b1r - a2i * b1i + b2r
    bi = a2r * b1i + a2i * b1r + b2i
    return (ar, ai, br, bi)


def s5_grouped(u, A_re, A_im, log_dt, B_re, B_im, C_re, C_im, D_skip):
    bsz, seq, _ = u.shape
    ug = u.reshape(bsz, seq, SSM_GROUPS, SSM_GROUP).astype(jnp.float32)
    dt = jnp.exp(log_dt.astype(jnp.float32))[:, None]
    a_re = A_re.astype(jnp.float32)
    a_im = A_im.astype(jnp.float32)
    mag = jnp.exp(dt * a_re)
    ang = dt * a_im
    lb_re = mag * jnp.cos(ang)
    lb_im = mag * jnp.sin(ang)
    den = a_re * a_re + a_im * a_im
    nr = lb_re - 1.0
    ni = lb_im
    f_re = (nr * a_re + ni * a_im) / den
    f_im = (ni * a_re - nr * a_im) / den
    br = B_re.astype(jnp.float32)
    bi = B_im.astype(jnp.float32)
    bb_re = f_re[..., None] * br - f_im[..., None] * bi
    bb_im = f_re[..., None] * bi + f_im[..., None] * br
    bu_re = jnp.einsum('bsgh,gph->bsgp', ug, bb_re)
    bu_im = jnp.einsum('bsgh,gph->bsgp', ug, bb_im)
    al_re = jnp.broadcast_to(lb_re, bu_re.shape)
    al_im = jnp.broadcast_to(lb_im, bu_im.shape)
    _, _, xs_re, xs_im = lax.associative_scan(
        _complex_linear_combine, (al_re, al_im, bu_re, bu_im), axis=1)
    y = (jnp.einsum('bsgp,ghp->bsgh', xs_re, C_re.astype(jnp.float32))
         - jnp.einsum('bsgp,ghp->bsgh', xs_im, C_im.astype(jnp.float32))
         + D_skip.astype(jnp.float32) * ug)
    return y.reshape(bsz, seq, SSM_WIDTH).astype(u.dtype)


def memory_cross_attention(h, m, wq, wk, wv, wo):
    bsz, seq, _ = h.shape
    q = (h @ wq).reshape(bsz, seq, XATTN_HEADS, XATTN_HEAD_DIM)
    k = (m @ wk).reshape(bsz, m.shape[1], XATTN_HEADS, XATTN_HEAD_DIM)
    v = (m @ wv).reshape(bsz, m.shape[1], XATTN_HEADS, XATTN_HEAD_DIM)
    s = jnp.einsum('bqhd,bkhd->bhqk', q, k).astype(jnp.float32) * (XATTN_HEAD_DIM ** -0.5)
    p = jax.nn.softmax(s, axis=-1).astype(v.dtype)
    o = jnp.einsum('bhqk,bkhd->bqhd', p, v).reshape(bsz, seq, XATTN_WIDTH)
    return o @ wo


def setup_inputs(seed: int = 0) -> dict:
    key = jax.random.key(seed)
    ks = jax.random.split(key, 32)

    def nrm(k, shape, scale):
        return jax.random.normal(k, shape, jnp.float32) * scale

    def gain(k):
        return 1.0 + 0.02 * jax.random.normal(k, (DEPTH, D_MODEL), jnp.float32)

    L = DEPTH
    n_idx = jnp.arange(SSM_STATE, dtype=jnp.float32)
    return {
        "x": nrm(ks[0], (BATCH, SEQ, D_MODEL), 1.0),
        "mem": nrm(ks[1], (BATCH, MEM_LEN, D_MODEL), 1.0),
        "g_mix": gain(ks[2]),
        "w_in": nrm(ks[3], (L, D_MODEL, IN_WIDTH), D_MODEL ** -0.5),
        "b_f": jax.random.uniform(ks[4], (L, ATTN_HEADS), jnp.float32, 1.0, 6.0),
        "b_gate": nrm(ks[5], (L, N_BRANCH * D_MODEL), 0.02),
        "A_re": -0.5 + nrm(ks[6], (L, SSM_GROUPS, SSM_STATE), 0.01),
        "A_im": math.pi * n_idx + nrm(ks[7], (L, SSM_GROUPS, SSM_STATE), 0.01),
        "log_dt": jax.random.uniform(ks[8], (L, SSM_GROUPS), jnp.float32,
                                     math.log(DT_MIN), math.log(DT_MAX)),
        "B_re": nrm(ks[9], (L, SSM_GROUPS, SSM_STATE, SSM_GROUP), (2 * SSM_GROUP) ** -0.5),
        "B_im": nrm(ks[10], (L, SSM_GROUPS, SSM_STATE, SSM_GROUP), (2 * SSM_GROUP) ** -0.5),
        "C_re": nrm(ks[11], (L, SSM_GROUPS, SSM_GROUP, SSM_STATE), (2 * SSM_STATE) ** -0.5),
        "C_im": nrm(ks[12], (L, SSM_GROUPS, SSM_GROUP, SSM_STATE), (2 * SSM_STATE) ** -0.5),
        "D_skip": nrm(ks[13], (L, SSM_GROUPS, SSM_GROUP), 1.0),
        "w_glu": nrm(ks[14], (L, SSM_WIDTH, SSM_WIDTH), SSM_WIDTH ** -0.5),
        "b_glu": nrm(ks[15], (L, SSM_WIDTH), 0.02),
        "w_attn_up": nrm(ks[16], (L, ATTN_WIDTH, D_MODEL), ATTN_WIDTH ** -0.5),
        "w_ssm_up": nrm(ks[17], (L, SSM_WIDTH, D_MODEL), SSM_WIDTH ** -0.5),
        "w_out": nrm(ks[18], (L, D_MODEL, D_MODEL), D_MODEL ** -0.5),
        "g_xattn": gain(ks[19]),
        "g_mem": gain(ks[20]),
        "wq_x": nrm(ks[21], (L, D_MODEL, XATTN_WIDTH), D_MODEL ** -0.5),
        "wk_x": nrm(ks[22], (L, D_MODEL, XATTN_WIDTH), D_MODEL ** -0.5),
        "wv_x": nrm(ks[23], (L, D_MODEL, XATTN_WIDTH), D_MODEL ** -0.5),
        "wo_x": nrm(ks[24], (L, XATTN_WIDTH, D_MODEL), XATTN_WIDTH ** -0.5),
        "g_mlp": gain(ks[25]),
        "w_ff1": nrm(ks[26], (L, D_MODEL, D_FF), D_MODEL ** -0.5),
        "w_ff2": nrm(ks[27], (L, D_FF, D_MODEL), D_FF ** -0.5),
        "g_final": 1.0 + 0.02 * jax.random.normal(ks[28], (D_MODEL,), jnp.float32),
    }


def reference(x, mem, g_mix, w_in, b_f, b_gate, A_re, A_im, log_dt, B_re, B_im, C_re, C_im,
              D_skip, w_glu, b_glu, w_attn_up, w_ssm_up, w_out, g_xattn, g_mem, wq_x, wk_x,
              wv_x, wo_x, g_mlp, w_ff1, w_ff2, g_final):
    bsz, seq, _ = x.shape
    for l in range(DEPTH):
        h = rmsnorm(x, g_mix[l])
        proj = h @ w_in[l]
        q = proj[..., OFF_Q:OFF_K].reshape(bsz, seq, ATTN_HEADS, ATTN_HEAD_DIM)
        k = proj[..., OFF_K:OFF_V].reshape(bsz, seq, ATTN_HEADS, ATTN_HEAD_DIM)
        v = proj[..., OFF_V:OFF_F].reshape(bsz, seq, ATTN_HEADS, ATTN_HEAD_DIM)
        log_f = jax.nn.log_sigmoid((proj[..., OFF_F:OFF_U] + b_f[l]).astype(jnp.float32))
        u = proj[..., OFF_U:OFF_G]
        gates = jax.nn.sigmoid((proj[..., OFF_G:] + b_gate[l]).astype(jnp.float32)).astype(x.dtype)
        g_attn = gates[..., :D_MODEL]
        g_ssm = gates[..., D_MODEL:]

        attn = forgetting_attention(q, k, v, log_f) @ w_attn_up[l]

        y = s5_grouped(u, A_re[l], A_im[l], log_dt[l], B_re[l], B_im[l],
                       C_re[l], C_im[l], D_skip[l])
        y = jax.nn.gelu(y)
        y = y * jax.nn.sigmoid(y @ w_glu[l] + b_glu[l])
        ssm = y @ w_ssm_up[l]

        x = x + (g_attn * attn + g_ssm * ssm) @ w_out[l]

        x = x + memory_cross_attention(rmsnorm(x, g_xattn[l]), rmsnorm(mem, g_mem[l]),
                                       wq_x[l], wk_x[l], wv_x[l], wo_x[l])

        hm = rmsnorm(x, g_mlp[l])
        x = x + jnp.square(jax.nn.relu(hm @ w_ff1[l])) @ w_ff2[l]
    return rmsnorm(x, g_final)
```

```cpp
#include <hip/hip_runtime.h>
#include <hip/hip_bf16.h>
#include <cstdio>
#include <cstdint>

#ifndef MK_N_LAUNCHES
#define MK_N_LAUNCHES 1
#endif

#define GAS __attribute__((address_space(1)))
#define LAS __attribute__((address_space(3)))
typedef unsigned short bf16_t;
typedef short bf16x8 __attribute__((ext_vector_type(8)));
typedef short s16x4 __attribute__((ext_vector_type(4)));
typedef float f32x2 __attribute__((ext_vector_type(2)));
typedef float f32x4 __attribute__((ext_vector_type(4)));
typedef float f32x16 __attribute__((ext_vector_type(16)));
typedef unsigned u32x2 __attribute__((ext_vector_type(2)));
typedef unsigned u32x4 __attribute__((ext_vector_type(4)));

constexpr int BATCH = 2, SEQ = 8192, DM = 4096, M = BATCH * SEQ;
constexpr int AW = 2048, AH = 16, ADH = 128;
constexpr int SW = 1024, SG = 64, SGC = 16, SP = 64;
constexpr int INW = 15376, OFF_F = 6144, OFF_U = 6160, OFF_G = 7184;
constexpr int MEML = 256, XH = 4, XDH = 256, XW = 1024;
constexpr int DFF = 16384;
constexpr float EPS = 1e-6f;
constexpr int CT = 32, NCH = SEQ / CT, UR = BATCH * NCH, UK = CT * SGC + 2 * SP;
constexpr int WIN_ROWS = 15376;
constexpr int WIN_F = 15360;
constexpr float S_WAU = 127.0f / (4.0f * 0.02209708691207961f);
constexpr float S_H = 127.0f / 4.5f, S_W = 127.0f * 64.0f / 4.0f, S_X1 = 127.0f / 5.0f;
constexpr float QSCALE_X = 0.0625f * 1.4426950408889634f;
constexpr float ATT_ISCALE = 11.313708498984761f;

constexpr size_t MiB = 1u << 20;
constexpr size_t WS_CTL = 0, CTL_ZERO_BYTES = 1 * MiB;
constexpr size_t WS_LOGF = 1 * MiB, WS_CPR = 2 * MiB, WS_KERN = 3 * MiB, WS_LB32 = 5 * MiB, WS_KXB = 6 * MiB, WS_VXTB = 7 * MiB, WS_MN = 8 * MiB;
constexpr size_t WS_SS1 = 12 * MiB, WS_SS2 = 16 * MiB, WS_SS3 = 20 * MiB;
constexpr size_t WS_XB = 24 * MiB;
constexpr size_t WS_O = WS_XB, WS_Y = WS_XB + 64 * MiB, WS_Y2 = WS_XB + 96 * MiB;
constexpr size_t WS_FF1 = 152 * MiB, WS_FF2 = 280 * MiB;
constexpr size_t WS_WIN = 408 * MiB;
constexpr size_t WS_KS = WS_WIN, WS_VS = WS_WIN + 16 * MiB, WS_MERGED = WS_WIN;
constexpr size_t WS_WOUT = 536 * MiB, WS_WAU = 568 * MiB, WS_WSU = 584 * MiB, WS_WGLU = 592 * MiB, WS_WQ = 594 * MiB, WS_WK = 602 * MiB, WS_WV = 610 * MiB, WS_WO = 618 * MiB;
constexpr size_t WS_Q = 626 * MiB, WS_K = 690 * MiB, WS_V = 754 * MiB;
constexpr size_t WS_QX = WS_Q, WS_PX = WS_Q + 32 * MiB, WS_OX = WS_K;
constexpr size_t WS_UG = 818 * MiB, WS_KT = 858 * MiB, WS_WEND = 898 * MiB;
constexpr size_t WS_GATES = 914 * MiB;
constexpr size_t WS_HID = 408 * MiB;
constexpr size_t WS_END = 1170 * MiB;
static_assert(WS_K == WS_Q + (size_t)M * AW * 2 && WS_V == WS_K + (size_t)M * AW * 2, "q k v contiguous");
static_assert(WS_HID + (size_t)M * DFF * 2 <= WS_END && WS_GATES + (size_t)M * 8192 * 2 <= WS_END && WS_WIN + (size_t)WIN_ROWS * DM * 2 <= WS_WOUT, "ws map");
static_assert(WS_UG + (size_t)SG * UR * UK * 2 <= WS_KT && WS_KT + (size_t)SG * UR * UK * 2 <= WS_WEND && WS_WEND + (size_t)SG * 256 * 512 * 2 <= 914 * MiB, "ws map s5");

constexpr int CW_TMO = 0, CW_CODE = 1, CW_QUEUE = 64, CW_CONVQ = 128, CW_BAR = 4096;

constexpr int RING_BYTES = 131072;
constexpr int NCONV = 0, CONVCH = 8;
constexpr int LDSCTL_OFF = RING_BYTES, MISC_OFF = LDSCTL_OFF + 320;
constexpr int LDS_BYTES = 147456;
constexpr int NWAVES = 8;

#define LDS_WAIT() asm volatile("s_waitcnt lgkmcnt(0)" ::: "memory")
#define VM_WAIT() asm volatile("s_waitcnt vmcnt(0)" ::: "memory")
typedef __bf16 bf16x2_t __attribute__((ext_vector_type(2)));
__device__ __forceinline__ unsigned cvt_pk_bf16(float lo, float hi) { const f32x2 v = {lo, hi}; const bf16x2_t b = __builtin_convertvector(v, bf16x2_t); return __builtin_bit_cast(unsigned, b); }
__device__ __forceinline__ unsigned pk4_u8(float a, float b, float c, float d) {
    const unsigned x = (unsigned)fmaf(a, 255.f, 0.5f), y = (unsigned)fmaf(b, 255.f, 0.5f), z = (unsigned)fmaf(c, 255.f, 0.5f), w = (unsigned)fmaf(d, 255.f, 0.5f);
    return x | (y << 8) | (z << 16) | (w << 24);
}
__device__ __forceinline__ void unpack8u(const u32x2 g, f32x4& g0, f32x4& g1) {
    g0 = (f32x4){(float)(g.x & 0xffu), (float)((g.x >> 8) & 0xffu), (float)((g.x >> 16) & 0xffu), (float)(g.x >> 24)};
    g1 = (f32x4){(float)(g.y & 0xffu), (float)((g.y >> 8) & 0xffu), (float)((g.y >> 16) & 0xffu), (float)(g.y >> 24)};
}
__device__ __forceinline__ unsigned pk4_i8(float a, float b, float c, float d) {
    const int ia = (int)fminf(fmaxf(rintf(a), -127.f), 127.f), ib = (int)fminf(fmaxf(rintf(b), -127.f), 127.f), ic = (int)fminf(fmaxf(rintf(c), -127.f), 127.f), id = (int)fminf(fmaxf(rintf(d), -127.f), 127.f);
    return ((unsigned)ia & 255u) | (((unsigned)ib & 255u) << 8) | (((unsigned)ic & 255u) << 16) | ((unsigned)id << 24);
}
__device__ __forceinline__ unsigned pk4_fp8(float a, float b, float c, float d) { unsigned w = 0u; w = __builtin_amdgcn_cvt_pk_fp8_f32(a, b, w, false); w = __builtin_amdgcn_cvt_pk_fp8_f32(c, d, w, true); return w; }
__device__ __forceinline__ float bf_lo(unsigned w) { return __uint_as_float(w << 16); }
__device__ __forceinline__ float bf_hi(unsigned w) { return __uint_as_float(w & 0xffff0000u); }
__device__ __forceinline__ u32x4 pack8f(f32x4 a, f32x4 b) { u32x4 w; w.x = cvt_pk_bf16(a[0], a[1]); w.y = cvt_pk_bf16(a[2], a[3]); w.z = cvt_pk_bf16(b[0], b[1]); w.w = cvt_pk_bf16(b[2], b[3]); return w; }
__device__ __forceinline__ void unpack8f(u32x4 w, f32x4& a, f32x4& b) { a = (f32x4){bf_lo(w.x), bf_hi(w.x), bf_lo(w.y), bf_hi(w.y)}; b = (f32x4){bf_lo(w.z), bf_hi(w.z), bf_lo(w.w), bf_hi(w.w)}; }
__device__ __forceinline__ float sigmoidf_fast(float v) { return __builtin_amdgcn_rcpf(1.0f + __builtin_amdgcn_exp2f(-1.4426950408889634f * v)); }
__device__ __forceinline__ float wave_sum(float v) {
#pragma unroll
    for (int o = 1; o < 64; o <<= 1) v += __shfl_xor(v, o);
    return v;
}

namespace pg8 {
constexpr int BM = 256, BK = 64, HALF = 128, HTB = HALF * BK * 2, STAGE_BYTES = 8 * HTB, NXCD = 8, WGM = 8;
__host__ __device__ __forceinline__ int lds_byte(int r, int c) { const int st = (r >> 4) * 2 + (c >> 5), rr = r & 15, cc = c & 31, ob = rr * 64 + cc * 2; return st * 1024 + (ob ^ (((ob >> 9) & 1) << 5)); }
__host__ __device__ __forceinline__ void stage_rc(int b, int& R, int& C) { const int st = b / 1024, sb = b % 1024, swz = sb ^ (((sb >> 9) & 1) << 5); R = (st >> 1) * 16 + swz / 64; C = (st & 1) * 32 + (swz % 64) / 2; }
__host__ __device__ __forceinline__ int perm32(int rho) { const int n = rho >> 4, i = rho & 15; return 8 * (i >> 2) + 4 * n + (i & 3); }

struct Unit { int pm, pn, pz; const char* a; const char* b; };
struct Gemm { int lda, ldb, K; };

struct PlainOrder {
    const bf16_t* A; const bf16_t* Bt; int lda, ldb, nM, nN, nwg, G, c;
    __device__ void init(const bf16_t* A_, const bf16_t* Bt_, int lda_, int ldb_, int Mr, int Nr, int G_, int c_) { A = A_; Bt = Bt_; lda = lda_; ldb = ldb_; nM = Mr / BM; nN = Nr / BM; nwg = nM * nN; G = G_; c = c_; }
    __device__ bool next(int i, Unit& u) const {
        const long L = (long)i * G + c; if (L >= nwg) return false;
        int wgid = (int)L; { const int q = nwg / NXCD, r = nwg % NXCD, xcd = wgid % NXCD, off = wgid / NXCD; wgid = (xcd < r ? xcd * (q + 1) : r * (q + 1) + (xcd - r) * q) + off; }
        const int nig = WGM * nN, gid = wgid / nig, fm = gid * WGM, gsz = (nM - fm) < WGM ? (nM - fm) : WGM;
        u.pm = fm + ((wgid % nig) % gsz); u.pn = (wgid % nig) / gsz; u.pz = 0;
        u.a = (const char*)A + (size_t)u.pm * BM * lda * 2; u.b = (const char*)Bt + (size_t)u.pn * BM * ldb * 2; return true;
    }
};

struct DownOrder {
    PlainOrder P; const bf16_t* A; const bf16_t* Bt; int lda, ldb, c;
    __device__ bool next(int i, Unit& u) const { if (P.G != 256) return P.next(i, u); if (i >= 4) return false; const int x = c & 7, rk = c >> 3;
        u.pm = 16 * i + 4 * (x >> 1) + (rk & 3); u.pn = 8 * (x & 1) + (rk >> 2); u.pz = 0;
        u.a = (const char*)A + (size_t)u.pm * BM * lda * 2; u.b = (const char*)Bt + (size_t)u.pn * BM * ldb * 2; return true; }
};
#define PG8_ACC const f32x4 (&acc)[2][2][4][2]
typedef int i32x4 __attribute__((ext_vector_type(4)));
typedef int i32x8 __attribute__((ext_vector_type(8)));
__device__ __forceinline__ void mfma8_inplace(f32x4& c, i32x8 a, i32x8 b, int sc) { asm volatile("v_mfma_scale_f32_16x16x128_f8f6f4 %0, %1, %2, %0, %3, %3 op_sel_hi:[0,0,0]" : "+v"(c) : "v"(a), "v"(b), "v"(sc)); }
__device__ __forceinline__ i32x8 cat8(bf16x8 a, bf16x8 b) { return __builtin_shufflevector(__builtin_bit_cast(i32x4, a), __builtin_bit_cast(i32x4, b), 0, 1, 2, 3, 4, 5, 6, 7); }

template <class Epi, class Sched, bool ALIGN_EPI, int PREC = 0>
__device__ __forceinline__ void gemm_phase(LAS unsigned char* lds, const Gemm g, const Sched& S, const Epi& E) {
    int tid = threadIdx.x; asm volatile("" : "+v"(tid));
    const int wid = __builtin_amdgcn_readfirstlane(tid >> 6), lane = tid & 63, wr = wid >> 2, wc = wid & 3, fr = lane & 15, fq = lane >> 4;
    const int K = g.K, nt = K / BK;
    unsigned voffA[2], voffB[2];
#pragma unroll
    for (int i = 0; i < 2; ++i) { int R, C; stage_rc(tid * 16 + i * 8192, R, C); const int Rb = Epi::PERM ? ((R & ~31) + perm32(R & 31)) : R;
        voffA[i] = (unsigned)(R * g.lda + C) * 2u; voffB[i] = (unsigned)(Rb * g.ldb + C) * 2u; }
    const size_t kstep = (size_t)(BK * 2);
    const size_t hstepA = (size_t)HALF * g.lda * 2, hstepB = (size_t)HALF * g.ldb * 2;
    const unsigned ldsw = (unsigned)wid * 1024u;
    const int aoff = lds_byte(wr * 64 + fr, fq * 8), boff = lds_byte(wc * 32 + fr, fq * 8);
#define PG8_SA(b, h) (((b) * 2 + (h)) * HTB)
#define PG8_SB(b, h) ((4 + (b) * 2 + (h)) * HTB)
#define PG8_STAGE(bufoff, gbase, voff) do { const __amdgpu_buffer_rsrc_t rs_ = __builtin_amdgcn_make_buffer_rsrc((void*)(gbase), 0, 0x7fffffff, 0x00020000); _Pragma("unroll") for (int _i = 0; _i < 2; ++_i) \
        __builtin_amdgcn_raw_ptr_buffer_load_lds(rs_, (LAS unsigned*)(lds + (bufoff) + ldsw + _i * 8192), 16, (int)(voff)[_i], 0, 0, 0); } while (0)
#define PG8_LDA(dst, b, h) do { _Pragma("unroll") for (int m = 0; m < 4; ++m) _Pragma("unroll") for (int k = 0; k < 2; ++k) dst[m][k] = *(const LAS bf16x8*)(lds + PG8_SA(b, h) + aoff + m * 2048 + k * 1024); } while (0)
#define PG8_LDB(dst, b, h) do { _Pragma("unroll") for (int n = 0; n < 2; ++n) _Pragma("unroll") for (int k = 0; k < 2; ++k) dst[n][k] = *(const LAS bf16x8*)(lds + PG8_SB(b, h) + boff + n * 2048 + k * 1024); } while (0)
#define PG8_MMA(ai, bj, At, Bt) do { __builtin_amdgcn_s_setprio(1); _Pragma("unroll") for (int m = 0; m < 4; ++m) _Pragma("unroll") for (int n = 0; n < 2; ++n) { \
        if constexpr (PREC == 1) { mfma8_inplace(acc[ai][bj][m][n], cat8(Bt[n][0], Bt[n][1]), cat8(At[m][0], At[m][1]), sc8); } \
        else if constexpr (PREC == 2) { _Pragma("unroll") for (int k = 0; k < 2; ++k) acc[ai][bj][m][n] = __builtin_bit_cast(f32x4, __builtin_amdgcn_mfma_i32_16x16x64_i8(__builtin_bit_cast(i32x4, Bt[n][k]), __builtin_bit_cast(i32x4, At[m][k]), __builtin_bit_cast(i32x4, acc[ai][bj][m][n]), 0, 0, 0)); } \
        else { _Pragma("unroll") for (int k = 0; k < 2; ++k) acc[ai][bj][m][n] = __builtin_amdgcn_mfma_f32_16x16x32_bf16(Bt[n][k], At[m][k], acc[ai][bj][m][n], 0, 0, 0); } } \
        __builtin_amdgcn_s_setprio(0); } while (0)
#define PG8_WAIT_V(n) asm volatile("s_waitcnt vmcnt(" #n ")" ::: "memory")
#define PG8_WAIT_L(n) asm volatile("s_waitcnt lgkmcnt(" #n ")" ::: "memory")
#define PG8_BAR __builtin_amdgcn_s_barrier()
#define PG8_SCHED __builtin_amdgcn_sched_barrier(0)
    Unit cur, nxt; int ui = 0;
    if (!S.next(0, cur)) return;
    f32x4 acc[2][2][4][2];
#pragma unroll
    for (int a = 0; a < 2; ++a)
#pragma unroll
        for (int b = 0; b < 2; ++b)
#pragma unroll
            for (int m = 0; m < 4; ++m)
#pragma unroll
                for (int n = 0; n < 2; ++n) acc[a][b][m][n] = (f32x4){0.f, 0.f, 0.f, 0.f};
    bf16x8 At[4][2], B0[2][2], B1[2][2];
    int sc8 = 0x7F7F7F7F; asm volatile("" : "+v"(sc8));
    const char* cA = cur.a; const char* cB = cur.b;
    PG8_STAGE(PG8_SB(0, 0), cB, voffB); PG8_STAGE(PG8_SB(0, 1), cB + hstepB, voffB); PG8_STAGE(PG8_SA(0, 0), cA, voffA); PG8_STAGE(PG8_SA(0, 1), cA + hstepA, voffA);
    if (wr == 1) PG8_BAR;
    PG8_WAIT_V(2); PG8_BAR;
    PG8_STAGE(PG8_SB(1, 0), cB + kstep, voffB); PG8_STAGE(PG8_SA(1, 0), cA + kstep, voffA); PG8_STAGE(PG8_SB(1, 1), cB + hstepB + kstep, voffB);
    PG8_WAIT_V(6); PG8_BAR;
    for (;;) {
        const bool has_next = S.next(ui + 1, nxt);
        const char* nA = has_next ? nxt.a : cA; const char* nB = has_next ? nxt.b : cB;
        for (int t = 0; t < nt; t += 2) {
            const bool last = (t == nt - 2);
            const char* a1 = cA + (size_t)(t + 1) * kstep;
            const char* a2 = last ? nA : cA + (size_t)(t + 2) * kstep; const char* b2 = last ? nB : cB + (size_t)(t + 2) * kstep;
            const char* a3 = a2 + kstep; const char* b3 = b2 + kstep;
            PG8_LDB(B0, 0, 0); PG8_LDB(B1, 0, 1); PG8_SCHED; PG8_LDA(At, 0, 0); PG8_STAGE(PG8_SA(1, 1), a1 + hstepA, voffA);
            PG8_WAIT_V(8); PG8_WAIT_L(0); PG8_BAR; PG8_MMA(0, 0, At, B0); PG8_MMA(0, 1, At, B1); PG8_BAR; PG8_SCHED;
            PG8_LDA(At, 0, 1); PG8_STAGE(PG8_SB(0, 0), b2, voffB); PG8_STAGE(PG8_SB(0, 1), b2 + hstepB, voffB); PG8_STAGE(PG8_SA(0, 0), a2, voffA);
            PG8_WAIT_V(8); PG8_WAIT_L(0); PG8_BAR; PG8_MMA(1, 0, At, B0); PG8_MMA(1, 1, At, B1); PG8_BAR; PG8_SCHED;
            PG8_LDB(B0, 1, 0); PG8_LDB(B1, 1, 1); PG8_SCHED; PG8_LDA(At, 1, 0); PG8_STAGE(PG8_SA(0, 1), a2 + hstepA, voffA);
            PG8_WAIT_V(8); PG8_WAIT_L(0); PG8_BAR; PG8_MMA(0, 0, At, B0); PG8_MMA(0, 1, At, B1); PG8_BAR; PG8_SCHED;
            PG8_LDA(At, 1, 1); PG8_STAGE(PG8_SB(1, 0), b3, voffB); PG8_STAGE(PG8_SB(1, 1), b3 + hstepB, voffB); PG8_STAGE(PG8_SA(1, 0), a3, voffA);
            PG8_WAIT_V(8); PG8_WAIT_L(0); PG8_BAR; PG8_MMA(1, 0, At, B0); PG8_MMA(1, 1, At, B1); PG8_BAR; PG8_SCHED;
        }
        if constexpr (PREC == 1) { asm volatile("s_nop 15\n\ts_nop 15" ::: "memory"); }
        if constexpr (ALIGN_EPI) { if (wr == 0) PG8_BAR; }
        if constexpr (!Epi::AFTER_DRAIN) { E(acc, cur, wr, wc, fr, fq); }
        if (!has_next) break;
#pragma unroll
        for (int a = 0; a < 2; ++a)
#pragma unroll
            for (int b = 0; b < 2; ++b)
#pragma unroll
                for (int m = 0; m < 4; ++m)
#pragma unroll
                    for (int n = 0; n < 2; ++n) acc[a][b][m][n] = (f32x4){0.f, 0.f, 0.f, 0.f};
        cur = nxt; cA = nA; cB = nB; ++ui;
        if constexpr (ALIGN_EPI) { if (wr == 1) PG8_BAR; }
    }
    PG8_WAIT_V(0);
    if constexpr (!ALIGN_EPI) { if (wr == 0) PG8_BAR; }
    PG8_BAR;
    if constexpr (Epi::AFTER_DRAIN) { E.fused(acc, cur, wr, wc, fr, fq, lds, wid, lane); }
#undef PG8_SA
#undef PG8_SB
#undef PG8_STAGE
#undef PG8_LDA
#undef PG8_LDB
#undef PG8_MMA
#undef PG8_WAIT_V
#undef PG8_WAIT_L
#undef PG8_BAR
#undef PG8_SCHED
}

#define EPI_ROWS for (int ai = 0; ai < 2; ++ai) _Pragma("unroll") for (int m = 0; m < 4; ++m)
template <bool I8> __device__ __forceinline__ f32x4 accv(const f32x4& a) { if constexpr (I8) { const i32x4 i = __builtin_bit_cast(i32x4, a); return (f32x4){(float)i[0], (float)i[1], (float)i[2], (float)i[3]}; } else return a; }

template <bool I8> struct EpiProj {
    static constexpr bool PERM = true, AFTER_DRAIN = false;
    bf16_t* Q; bf16_t* Ug; float ascale;
    __device__ __forceinline__ void operator()(PG8_ACC, const Unit& u, int wr, int wc, int fr, int fq) const {
        const int pn = u.pn, row0 = u.pm * BM + wr * 64 + fr, cin = wc * 32 + 8 * fq;
        if (pn < 24) {
            bf16_t* base = Q + (size_t)(pn >> 3) * ((size_t)M * AW); const int hp = (pn & 7) * 2;
#pragma unroll
            EPI_ROWS { const int row = row0 + ai * HALF + m * 16, b = row >> 13, s = row & (SEQ - 1);
#pragma unroll
                for (int bj = 0; bj < 2; ++bj) { bf16_t* p = base + ((size_t)(b * AH + hp + bj) * SEQ + s) * ADH + cin; __builtin_nontemporal_store(pack8f(accv<I8>(acc[ai][bj][m][0]) * ascale, accv<I8>(acc[ai][bj][m][1]) * ascale), (u32x4*)p); } }
        } else {
#pragma unroll
            EPI_ROWS { const int row = row0 + ai * HALF + m * 16; const size_t rb = (size_t)(row >> 5) * UK + (row & 31) * SGC;
#pragma unroll
                for (int bj = 0; bj < 2; ++bj) { const int c = (pn - 24) * BM + bj * HALF + cin, gg = c >> 4, hh = c & 15;
                    bf16_t* p = Ug + (size_t)gg * UR * UK + rb + hh; __builtin_nontemporal_store(pack8f(accv<I8>(acc[ai][bj][m][0]) * ascale, accv<I8>(acc[ai][bj][m][1]) * ascale), (u32x4*)p); } }
        }
    }
};
template <bool I8> struct EpiGates8 {
    static constexpr bool PERM = true, AFTER_DRAIN = false;
    unsigned char* Gt; const float* b_gate; float ascale;
    __device__ __forceinline__ void operator()(PG8_ACC, const Unit& u, int wr, int wc, int fr, int fq) const {
        const int row0 = u.pm * BM + wr * 64 + fr, c0 = u.pn * BM + wc * 32 + 8 * fq; f32x4 bv[2][2];
#pragma unroll
        for (int bj = 0; bj < 2; ++bj)
#pragma unroll
            for (int n = 0; n < 2; ++n) bv[bj][n] = *(const f32x4*)(b_gate + c0 + bj * HALF + 4 * n);
#pragma unroll
        EPI_ROWS { const int row = row0 + ai * HALF + m * 16; unsigned char* rp = Gt + (size_t)row * 8192 + c0;
#pragma unroll
            for (int bj = 0; bj < 2; ++bj) { f32x4 v0 = accv<I8>(acc[ai][bj][m][0]) * ascale + bv[bj][0], v1 = accv<I8>(acc[ai][bj][m][1]) * ascale + bv[bj][1];
#pragma unroll
                for (int j = 0; j < 4; ++j) { v0[j] = sigmoidf_fast(v0[j]); v1[j] = sigmoidf_fast(v1[j]); }
                u32x2 w8; w8.x = pk4_u8(v0[0], v0[1], v0[2], v0[3]); w8.y = pk4_u8(v1[0], v1[1], v1[2], v1[3]); __builtin_nontemporal_store(w8, (u32x2*)(rp + bj * HALF)); } }
    }
};
struct EpiProjGates {
    static constexpr bool PERM = true, AFTER_DRAIN = false;
    EpiProj<true> p; EpiGates8<true> g;
    __device__ __forceinline__ void operator()(PG8_ACC, const Unit& u, int wr, int wc, int fr, int fq) const {
        if (u.pn < 28) p(acc, u, wr, wc, fr, fq); else { Unit v = u; v.pn = u.pn - 28; g(acc, v, wr, wc, fr, fq); }
    }
};
struct EpiKV {
    static constexpr bool PERM = false, AFTER_DRAIN = false;
    float* KS; float* VS;
    __device__ __forceinline__ void operator()(PG8_ACC, const Unit& u, int wr, int wc, int fr, int fq) const {
        const bool isk = u.pz < 64; const int ks = u.pz & 7, ldc = isk ? 1024 : 512;
        float* C = (isk ? KS : VS) + (size_t)ks * 512 * 1024;
        const int row0 = u.pm * BM + wr * 64 + fr, col0 = u.pn * BM + wc * 32 + 4 * fq;
#pragma unroll
        EPI_ROWS { float* rowp = C + (size_t)(row0 + ai * HALF + m * 16) * ldc + col0;
#pragma unroll
            for (int bj = 0; bj < 2; ++bj)
#pragma unroll
                for (int n = 0; n < 2; ++n) *(f32x4*)(rowp + bj * HALF + n * 16) = acc[ai][bj][m][n]; }
    }
};
struct EpiS5End {
    static constexpr bool PERM = false, AFTER_DRAIN = true;
    bf16_t* Ug; const float* lb32;
    __device__ __forceinline__ void fused(f32x4 (&acc)[2][2][4][2], const Unit& u, int wr, int wc, int fr, int fq, LAS unsigned char* lds, int wid, int lane) const {
        LAS float* E = (LAS float*)lds;
#pragma unroll
        EPI_ROWS { const int r = ai * HALF + wr * 64 + m * 16 + fr;
#pragma unroll
            for (int n = 0; n < 2; ++n) *(LAS f32x4*)(E + r * 128 + wc * 32 + 16 * n + 4 * fq) = acc[ai][0][m][n]; }
        asm volatile("s_waitcnt lgkmcnt(0)" ::: "memory"); __builtin_amdgcn_s_barrier(); asm volatile("" ::: "memory");
        const int g = u.pz >> 1, b = u.pz & 1;
        if (wid == 0) {
            const int p = lane; const float lr = lb32[(g * SP + p) * 2], li = lb32[(g * SP + p) * 2 + 1];
            float xr = 0.f, xi = 0.f; bf16_t* dst = Ug + ((size_t)g * UR + b * NCH) * UK + CT * SGC + p;
#pragma unroll 8
            for (int c = 0; c < NCH; ++c) { const float er = E[c * 128 + p], ei = E[c * 128 + 64 + p];
                dst[(size_t)c * UK] = (bf16_t)(cvt_pk_bf16(xr, 0.f) & 0xffffu); dst[(size_t)c * UK + SP] = (bf16_t)(cvt_pk_bf16(xi, 0.f) & 0xffffu);
                const float nr = lr * xr - li * xi + er, ni = lr * xi + li * xr + ei; xr = nr; xi = ni; }
        }
        asm volatile("s_waitcnt lgkmcnt(0)" ::: "memory"); __builtin_amdgcn_s_barrier(); asm volatile("" ::: "memory");
    }
};
struct EpiS5Main {
    static constexpr bool PERM = true, AFTER_DRAIN = false;
    bf16_t* Y;
    __device__ __forceinline__ void operator()(PG8_ACC, const Unit& u, int wr, int wc, int fr, int fq) const {
        const int g = u.pz, row0 = u.pm * BM + wr * 64 + fr, cin = u.pn * BM + wc * 32 + 8 * fq;
#pragma unroll
        EPI_ROWS { const int R = row0 + ai * HALF + m * 16;
#pragma unroll
            for (int bj = 0; bj < 2; ++bj) { const int nidx = cin + bj * HALF, t = nidx >> 4, h = nidx & 15;
                f32x4 v[2] = {acc[ai][bj][m][0], acc[ai][bj][m][1]};
#pragma unroll
                for (int n = 0; n < 2; ++n)
#pragma unroll
                    for (int j = 0; j < 4; ++j) { const float y = v[n][j]; const float z2 = 1.5957691216057308f * (y + 0.044715f * y * y * y); v[n][j] = y * sigmoidf_fast(z2); }
                *(u32x4*)(Y + ((size_t)R * CT + t) * SW + g * SGC + h) = pack8f(v[0], v[1]); } }
    }
};
struct EpiGlu {
    static constexpr bool PERM = true, AFTER_DRAIN = false;
    const bf16_t* Y; bf16_t* Y2; const float* bias;
    __device__ __forceinline__ void operator()(PG8_ACC, const Unit& u, int wr, int wc, int fr, int fq) const {
        const int row0 = u.pm * BM + wr * 64 + fr, c0 = u.pn * BM + wc * 32 + 8 * fq; f32x4 bv[2][2];
#pragma unroll
        for (int bj = 0; bj < 2; ++bj)
#pragma unroll
            for (int n = 0; n < 2; ++n) bv[bj][n] = *(const f32x4*)(bias + c0 + bj * HALF + 4 * n);
#pragma unroll
        for (int ai = 0; ai < 2; ++ai) { u32x4 yy[4][2];
#pragma unroll
            for (int m = 0; m < 4; ++m)
#pragma unroll
                for (int bj = 0; bj < 2; ++bj) yy[m][bj] = *(const u32x4*)(Y + (size_t)(row0 + ai * HALF + m * 16) * SW + c0 + bj * HALF);
#pragma unroll
            for (int m = 0; m < 4; ++m)
#pragma unroll
                for (int bj = 0; bj < 2; ++bj) { f32x4 y0, y1; unpack8f(yy[m][bj], y0, y1);
                    f32x4 v0 = acc[ai][bj][m][0] + bv[bj][0], v1 = acc[ai][bj][m][1] + bv[bj][1];
#pragma unroll
                    for (int j = 0; j < 4; ++j) { v0[j] = y0[j] * sigmoidf_fast(v0[j]); v1[j] = y1[j] * sigmoidf_fast(v1[j]); }
                    *(u32x4*)(Y2 + (size_t)(row0 + ai * HALF + m * 16) * SW + c0 + bj * HALF) = pack8f(v0, v1); } }
    }
};
template <bool ADD, bool I8 = false> struct EpiGate {
    static constexpr bool PERM = true, AFTER_DRAIN = false;
    const unsigned char* Gt; int goff; bf16_t* O; const bf16_t* Oin; const float* dq; float winv;
    __device__ __forceinline__ void operator()(PG8_ACC, const Unit& u, int wr, int wc, int fr, int fq) const {
        const int row0 = u.pm * BM + wr * 64 + fr, c0 = u.pn * BM + wc * 32 + 8 * fq;
#pragma unroll
        for (int ai = 0; ai < 2; ++ai) { u32x2 gg[4][2]; u32x4 oo[4][2]; float rsc[4];
#pragma unroll
            for (int m = 0; m < 4; ++m) { rsc[m] = (I8 ? dq[row0 + ai * HALF + m * 16] * winv : 1.0f) * (1.0f / 255.f);
#pragma unroll
                for (int bj = 0; bj < 2; ++bj) { const int row = row0 + ai * HALF + m * 16; gg[m][bj] = *(const u32x2*)(Gt + (size_t)row * 8192 + goff + c0 + bj * HALF);
                    if (ADD) oo[m][bj] = *(const u32x4*)(Oin + (size_t)row * DM + c0 + bj * HALF); } }
#pragma unroll
            for (int m = 0; m < 4; ++m)
#pragma unroll
                for (int bj = 0; bj < 2; ++bj) { const int row = row0 + ai * HALF + m * 16; f32x4 g0, g1; unpack8u(gg[m][bj], g0, g1);
                    f32x4 v0 = accv<I8>(acc[ai][bj][m][0]) * g0 * rsc[m], v1 = accv<I8>(acc[ai][bj][m][1]) * g1 * rsc[m];
                    if (ADD) { f32x4 o0, o1; unpack8f(oo[m][bj], o0, o1); v0 += o0; v1 += o1; }
                    *(u32x4*)(O + (size_t)row * DM + c0 + bj * HALF) = pack8f(v0, v1); } }
    }
};
template <bool BASE_F32, bool I8 = false> struct EpiRes {
    static constexpr bool PERM = true, AFTER_DRAIN = false;
    const float* base32; bf16_t* XB; float* ss; bf16_t* XBo; unsigned char* X8o; float ascale; const float* dq;
    __device__ __forceinline__ void operator()(PG8_ACC, const Unit& u, int wr, int wc, int fr, int fq) const {
        const int row0 = u.pm * BM + wr * 64 + fr, c0 = u.pn * BM + wc * 32 + 8 * fq;
#pragma unroll
        for (int ai = 0; ai < 2; ++ai) {
            f32x4 bf[BASE_F32 ? 4 : 1][2][2]; u32x4 bh[BASE_F32 ? 1 : 4][2];
#pragma unroll
            for (int m = 0; m < 4; ++m)
#pragma unroll
                for (int bj = 0; bj < 2; ++bj) { const size_t o = (size_t)(row0 + ai * HALF + m * 16) * DM + c0 + bj * HALF;
                    if (BASE_F32) { bf[m][bj][0] = *(const f32x4*)(base32 + o); bf[m][bj][1] = *(const f32x4*)(base32 + o + 4); } else bh[m][bj] = *(const u32x4*)(XB + o); }
#pragma unroll
            for (int m = 0; m < 4; ++m) { const int row = row0 + ai * HALF + m * 16; float q = 0.f; const float asc = I8 ? dq[row] * ascale : ascale;
#pragma unroll
                for (int bj = 0; bj < 2; ++bj) { f32x4 b0, b1; if (BASE_F32) { b0 = bf[m][bj][0]; b1 = bf[m][bj][1]; } else unpack8f(bh[m][bj], b0, b1);
                    const f32x4 v0 = b0 + accv<I8>(acc[ai][bj][m][0]) * asc, v1 = b1 + accv<I8>(acc[ai][bj][m][1]) * asc;
                    q += ((v0[0] * v0[0] + v0[1] * v0[1]) + (v0[2] * v0[2] + v0[3] * v0[3])) + ((v1[0] * v1[0] + v1[1] * v1[1]) + (v1[2] * v1[2] + v1[3] * v1[3]));
                    *(u32x4*)(XBo + (size_t)row * DM + c0 + bj * HALF) = pack8f(v0, v1);
                    if (X8o) { const f32x4 q0 = v0 * S_X1, q1 = v1 * S_X1; u32x2 w8; w8.x = pk4_i8(q0[0], q0[1], q0[2], q0[3]); w8.y = pk4_i8(q1[0], q1[1], q1[2], q1[3]); *(u32x2*)(X8o + (size_t)row * DM + c0 + bj * HALF) = w8; } }
                q += __shfl_xor(q, 16); q += __shfl_xor(q, 32);
                if (fq == 0) ss[(size_t)row * 64 + u.pn * 4 + wc] = q; } }
    }
};
__device__ __forceinline__ float row_rstd(const float* ss, int row, int fq) {
    const f32x4* p = (const f32x4*)(ss + (size_t)row * 64 + fq * 16); const f32x4 a = p[0], b = p[1], c = p[2], d = p[3];
    float s = ((a[0] + a[1]) + (a[2] + a[3])) + ((b[0] + b[1]) + (b[2] + b[3])) + ((c[0] + c[1]) + (c[2] + c[3])) + ((d[0] + d[1]) + (d[2] + d[3]));
    s += __shfl_xor(s, 16); s += __shfl_xor(s, 32);
    return 1.0f / sqrtf(s * (1.0f / DM) + EPS);
}
template <int ACT, bool I8 = false> struct EpiNormed {
    static constexpr bool PERM = true, AFTER_DRAIN = false;
    const float* ss; bf16_t* O; int ldo; float scale; const LAS float* rs; int pm0;
    __device__ __forceinline__ void operator()(PG8_ACC, const Unit& u, int wr, int wc, int fr, int fq) const {
        const int row0 = u.pm * BM + wr * 64 + fr, c0 = u.pn * BM + wc * 32 + 8 * fq; const bool fast = (u.pm == pm0);
#pragma unroll
        EPI_ROWS { const int row = row0 + ai * HALF + m * 16; const float r = fast ? rs[wr * 64 + fr + ai * HALF + m * 16] : row_rstd(ss, row, fq) * scale;
#pragma unroll
            for (int bj = 0; bj < 2; ++bj) { f32x4 v0 = accv<I8>(acc[ai][bj][m][0]) * r, v1 = accv<I8>(acc[ai][bj][m][1]) * r;
                if (ACT == 1) {
#pragma unroll
                    for (int j = 0; j < 4; ++j) { const float a = fmaxf(v0[j], 0.f), b = fmaxf(v1[j], 0.f); v0[j] = a * a; v1[j] = b * b; } }
                __builtin_nontemporal_store(pack8f(v0, v1), (u32x4*)(O + (size_t)row * ldo + c0 + bj * HALF)); } }
    }
};
struct EpiSoftmax {
    static constexpr bool PERM = true, AFTER_DRAIN = true;
    bf16_t* P;
    __device__ __forceinline__ void fused(f32x4 (&acc)[2][2][4][2], const Unit& u, int wr, int wc, int fr, int fq, LAS unsigned char* lds, int wid, int lane) const {
        LAS float* Pm = (LAS float*)lds; LAS float* Ps = (LAS float*)(lds + 4096);
#pragma unroll
        EPI_ROWS { const int r = ai * HALF + wr * 64 + m * 16 + fr; float mx = -3.0e38f;
#pragma unroll
            for (int bj = 0; bj < 2; ++bj)
#pragma unroll
                for (int n = 0; n < 2; ++n)
#pragma unroll
                    for (int j = 0; j < 4; ++j) mx = fmaxf(mx, acc[ai][bj][m][n][j]);
            mx = fmaxf(mx, __shfl_xor(mx, 16)); mx = fmaxf(mx, __shfl_xor(mx, 32));
            if (fq == 0) Pm[r * 4 + wc] = mx; }
        asm volatile("s_waitcnt lgkmcnt(0)" ::: "memory"); __builtin_amdgcn_s_barrier(); asm volatile("" ::: "memory");
#pragma unroll
        EPI_ROWS { const int r = ai * HALF + wr * 64 + m * 16 + fr; const f32x4 mm = *(const LAS f32x4*)(Pm + r * 4);
            const float mx = fmaxf(fmaxf(mm[0], mm[1]), fmaxf(mm[2], mm[3])); float s = 0.f;
#pragma unroll
            for (int bj = 0; bj < 2; ++bj)
#pragma unroll
                for (int n = 0; n < 2; ++n)
#pragma unroll
                    for (int j = 0; j < 4; ++j) { const float e = __builtin_amdgcn_exp2f(acc[ai][bj][m][n][j] - mx); acc[ai][bj][m][n][j] = e; s += e; }
            s += __shfl_xor(s, 16); s += __shfl_xor(s, 32);
            if (fq == 0) Ps[r * 4 + wc] = s; }
        asm volatile("s_waitcnt lgkmcnt(0)" ::: "memory"); __builtin_amdgcn_s_barrier(); asm volatile("" ::: "memory");
        bf16_t* Pb = P + ((size_t)u.pz * SEQ + (size_t)u.pm * BM) * MEML;
#pragma unroll
        EPI_ROWS { const int r = ai * HALF + wr * 64 + m * 16 + fr; const f32x4 sv = *(const LAS f32x4*)(Ps + r * 4);
            const float inv = 1.0f / ((sv[0] + sv[1]) + (sv[2] + sv[3]));
#pragma unroll
            for (int bj = 0; bj < 2; ++bj) *(u32x4*)(Pb + (size_t)r * MEML + bj * HALF + wc * 32 + 8 * fq) = pack8f(acc[ai][bj][m][0] * inv, acc[ai][bj][m][1] * inv); }
        asm volatile("s_waitcnt lgkmcnt(0)" ::: "memory"); __builtin_amdgcn_s_barrier(); asm volatile("" ::: "memory");
    }
};
struct EpiXo {
    static constexpr bool PERM = true, AFTER_DRAIN = false;
    unsigned char* Ox;
    __device__ __forceinline__ void operator()(PG8_ACC, const Unit& u, int wr, int wc, int fr, int fq) const {
        const int b = u.pz >> 2, h = u.pz & 3; unsigned char* Ob = Ox + ((size_t)b * SEQ + (size_t)u.pm * BM) * XW + h * XDH + wc * 32 + 8 * fq;
#pragma unroll
        EPI_ROWS { const int r = ai * HALF + wr * 64 + m * 16 + fr;
#pragma unroll
            for (int bj = 0; bj < 2; ++bj) { const f32x4 v0 = acc[ai][bj][m][0] * 16.0f, v1 = acc[ai][bj][m][1] * 16.0f; u32x2 w8; w8.x = pk4_fp8(v0[0], v0[1], v0[2], v0[3]); w8.y = pk4_fp8(v1[0], v1[1], v1[2], v1[3]);
                *(u32x2*)(Ob + (size_t)r * XW + bj * HALF) = w8; } }
    }
};

struct S5EndOrder {
    const bf16_t* Ug; const bf16_t* Wend; int c;
    __device__ bool next(int i, Unit& u) const { if (i != 0 || c >= 2 * SG) return false; const int g = c >> 1, b = c & 1; u.pm = 0; u.pn = 0; u.pz = c;
        u.a = (const char*)(Ug + ((size_t)g * UR + b * NCH) * UK); u.b = (const char*)(Wend + (size_t)g * 256 * 512); return true; }
};
struct KVOrder {
    const bf16_t* MN; const bf16_t* WK; const bf16_t* WV; int c;
    __device__ bool next(int i, Unit& u) const { if (i != 0 || c < 128 || c >= 256) return false; const int j = c - 128, tile = j >> 3, ks = j & 7;
        if (tile < 8) { u.pm = tile >> 2; u.pn = tile & 3; u.pz = ks; u.a = (const char*)(MN + (size_t)u.pm * BM * DM + ks * 512); u.b = (const char*)(WK + (size_t)u.pn * BM * DM + ks * 512); }
        else { const int tt = tile - 8; u.pm = tt >> 1; u.pn = tt & 1; u.pz = 64 + ks; u.a = (const char*)(WV + (size_t)u.pm * BM * DM + ks * 512); u.b = (const char*)(MN + (size_t)u.pn * BM * DM + ks * 512); }
        return true; }
};
struct S5MainOrder {
    const bf16_t* Ug; const bf16_t* KT; int G, c;
    __device__ bool next(int i, Unit& u) const { const int L = i * G + c; if (L >= 4 * SG) return false; const int g = L >> 2; u.pm = (L >> 1) & 1; u.pn = L & 1; u.pz = g;
        u.a = (const char*)(Ug + ((size_t)g * UR + u.pm * BM) * UK); u.b = (const char*)(KT + ((size_t)g * UR + u.pn * BM) * UK); return true; }
};
struct QxOrder {
    const bf16_t* XBp; const bf16_t* WQp; int ld, G, c;
    __device__ bool next(int i, Unit& u) const { const int L = i * G + c; if (L >= 256) return false; const int bh = L >> 5, qt = L & 31, b = bh >> 2, h = bh & 3; u.pm = b * 32 + qt; u.pn = h; u.pz = 0;
        u.a = (const char*)(XBp + (size_t)u.pm * BM * ld); u.b = (const char*)(WQp + (size_t)h * BM * ld); return true; }
};
struct XsOrder {
    const bf16_t* QX; const bf16_t* KXB; int G, c;
    __device__ bool next(int i, Unit& u) const { const int L = i * G + c; if (L >= 256) return false; const int bh = L >> 5, qt = L & 31, b = bh >> 2, h = bh & 3; u.pm = qt; u.pn = 0; u.pz = bh;
        u.a = (const char*)(QX + ((size_t)b * SEQ + (size_t)qt * BM) * XW + h * XDH); u.b = (const char*)(KXB + (size_t)b * MEML * XW + h * XDH); return true; }
};
struct XoOrder {
    const bf16_t* PX; const bf16_t* VXTB; int G, c;
    __device__ bool next(int i, Unit& u) const { const int L = i * G + c; if (L >= 256) return false; const int bh = L >> 5, qt = L & 31, b = bh >> 2, h = bh & 3; u.pm = qt; u.pn = 0; u.pz = bh;
        u.a = (const char*)(PX + ((size_t)bh * SEQ + (size_t)qt * BM) * MEML); u.b = (const char*)(VXTB + (size_t)h * XDH * 512 + b * MEML); return true; }
};
}

namespace fox {
using bf16 = __hip_bfloat16;
constexpr int D = 128, NW = 8, QBLK = 32, KVBLK = 64, QB = NW * QBLK, OP = AW;
constexpr float SCALE = 0.08838834764831845f, THR = 8.f;
constexpr int SHM_V = KVBLK * D * 2, SHM_K = KVBLK * D * 2;
constexpr int LDS_CORE = 2 * SHM_V + 2 * SHM_K + NW * 64 * 4;
constexpr int LDS_C = LDS_CORE;
constexpr int LDS_TOTAL = LDS_C + SEQ * 4;
static_assert(LDS_TOTAL <= RING_BYTES, "fox lds");
#define KSWZ(row, colB) ((row) * 256 + ((colB) ^ (((row) & 7) << 4)))
#define SBAR() __builtin_amdgcn_sched_barrier(0)
__device__ __forceinline__ int v_st(int k, int c) { const int kk = (k & ~0xC) | ((k & 4) << 1) | ((k & 8) >> 1); return ((kk >> 3) * 4 + (c >> 5)) * 512 + ((kk & 7) * 32 + (c & 31)) * 2; }
__device__ __forceinline__ int v_rd_base(int lane) { return ((lane & 3) << 3) | (((lane >> 2) & 3) << 6) | (((lane >> 4) & 1) << 5) | (((lane >> 5) & 1) << 8); }
constexpr int v_rd_off(int d0, int ks, int half) { return d0 * 512 + ks * 4096 + half * 2048; }
__device__ __forceinline__ int crow(int r, int hi) { return (r & 3) + 8 * (r >> 2) + 4 * hi; }
__device__ __forceinline__ unsigned cvtpk(float lo, float hi) { return cvt_pk_bf16(lo, hi); }
__device__ __forceinline__ bf16x8 load8(const bf16* p) { return *reinterpret_cast<const bf16x8*>(p); }
__device__ __forceinline__ void mask_tile(f32x16& p0, f32x16& p1, int dq, unsigned W) {
    const float NEG = -__builtin_inff();
#pragma unroll
    for (int r = 0; r < 16; ++r) {
        const int c = (r & 3) + 8 * (r >> 2);
        if ((unsigned)(dq - c) >= W) p0[r] = NEG;
        if ((unsigned)(dq - c - 32) >= W) p1[r] = NEG;
    }
}
__device__ __forceinline__ void partialSM(f32x16& p0, f32x16& p1, float& m_reg, float& mn, float& alpha) {
    float pmax = p0[0]; for (int r = 1; r < 16; ++r) pmax = fmaxf(pmax, p0[r]); for (int r = 0; r < 16; ++r) pmax = fmaxf(pmax, p1[r]);
    { auto rr = __builtin_amdgcn_permlane32_swap(__float_as_uint(pmax), __float_as_uint(pmax), false, false);
      pmax = fmaxf(__uint_as_float(rr[0]), __uint_as_float(rr[1])); }
    constexpr float C2 = 1.4426950408889634f * SCALE;
    if (__builtin_expect(__all((pmax - m_reg) * SCALE <= THR), 1)) { mn = m_reg; alpha = 1.f; }
    else { mn = fmaxf(m_reg, pmax); alpha = __builtin_amdgcn_exp2f((m_reg - mn) * C2); m_reg = mn; }
    const float mnL = -mn * C2;
    for (int r = 0; r < 16; ++r) p0[r] = fmaf(p0[r], C2, mnL); for (int r = 0; r < 16; ++r) p1[r] = fmaf(p1[r], C2, mnL);
    for (int r = 0; r < 16; ++r) p0[r] = __builtin_amdgcn_exp2f(p0[r]);
}
__device__ __forceinline__ void finishSM(f32x16& p0, f32x16& p1, float alpha, float& l_reg, bf16x8& pa0, bf16x8& pa1, bf16x8& pa2, bf16x8& pa3) {
    for (int r = 0; r < 16; ++r) p1[r] = __builtin_amdgcn_exp2f(p1[r]);
    float ps = 0; for (int r = 0; r < 16; ++r) ps += p0[r]; for (int r = 0; r < 16; ++r) ps += p1[r];
    { auto rr = __builtin_amdgcn_permlane32_swap(__float_as_uint(ps), __float_as_uint(ps), false, false);
      ps = __uint_as_float(rr[0]) + __uint_as_float(rr[1]); }
    l_reg = l_reg * alpha + ps;
#define PK4(P, B_, OUT) do { unsigned a0 = cvtpk(P[B_+0], P[B_+1]), a1 = cvtpk(P[B_+2], P[B_+3]);                          \
        unsigned b0 = cvtpk(P[B_+4], P[B_+5]), b1 = cvtpk(P[B_+6], P[B_+7]);                                             \
        auto r0 = __builtin_amdgcn_permlane32_swap(a0, b0, false, false); auto r1 = __builtin_amdgcn_permlane32_swap(a1, b1, false, false); \
        u32x4 w = {r0[0], r1[0], r0[1], r1[1]}; OUT = *reinterpret_cast<bf16x8*>(&w); } while (0)
    PK4(p0, 0, pa0); PK4(p0, 8, pa1); PK4(p1, 0, pa2); PK4(p1, 8, pa3);
#undef PK4
}
template <int KB>
__device__ __forceinline__ void qkt(f32x16& p0, f32x16& p1, const char* K_lds, int r32, int hi, const bf16x8* qr, const float* ck) {
#pragma unroll
    for (int a = 0; a < 4; ++a) { const f32x4 c0 = *(const f32x4*)(ck + 8 * a), c1 = *(const f32x4*)(ck + 32 + 8 * a);
#pragma unroll
        for (int j = 0; j < 4; ++j) { p0[4 * a + j] = c0[j]; p1[4 * a + j] = c1[j]; } }
    const char* kb[4];
#pragma unroll
    for (int dd = 0; dd < 4; ++dd) kb[dd] = K_lds + KB * SHM_K + KSWZ(r32, (dd * 16 + hi * 8) * 2);
#pragma unroll
    for (int d0 = 0; d0 < 8; ++d0) { const char* a = kb[d0 & 3] + (d0 >> 2) * 128;
        bf16x8 b0 = *reinterpret_cast<const bf16x8*>(a);
        bf16x8 b1 = *reinterpret_cast<const bf16x8*>(a + 32 * 256);
        p0 = __builtin_amdgcn_mfma_f32_32x32x16_bf16(b0, qr[d0], p0, 0, 0, 0);
        p1 = __builtin_amdgcn_mfma_f32_32x32x16_bf16(b1, qr[d0], p1, 0, 0, 0); }
}
template <int VB>
__device__ __forceinline__ void pv_tile(f32x16* o, int vb0, bf16x8 pa0, bf16x8 pa1, bf16x8 pa2, bf16x8 pa3) {
#define TRRD(dst, off) asm volatile("ds_read_b64_tr_b16 %0, %1 offset:%2" : "=&v"(dst) : "v"(vb0), "i"(off) : "memory")
#define PV_D0(d0) do { s16x4 l0, l1, l2, l3, h0, h1, h2, h3; constexpr int b_ = VB * SHM_V + v_rd_off(d0, 0, 0); \
        TRRD(l0, b_); TRRD(h0, b_ + 2048); TRRD(l1, b_ + 4096); TRRD(h1, b_ + 6144); TRRD(l2, b_ + 8192); TRRD(h2, b_ + 10240); TRRD(l3, b_ + 12288); TRRD(h3, b_ + 14336); \
        asm volatile("s_waitcnt lgkmcnt(0)" ::: "memory"); SBAR();   \
        o[d0] = __builtin_amdgcn_mfma_f32_32x32x16_bf16(pa0, (bf16x8){l0[0], l0[1], l0[2], l0[3], h0[0], h0[1], h0[2], h0[3]}, o[d0], 0, 0, 0);   \
        o[d0] = __builtin_amdgcn_mfma_f32_32x32x16_bf16(pa1, (bf16x8){l1[0], l1[1], l1[2], l1[3], h1[0], h1[1], h1[2], h1[3]}, o[d0], 0, 0, 0);   \
        o[d0] = __builtin_amdgcn_mfma_f32_32x32x16_bf16(pa2, (bf16x8){l2[0], l2[1], l2[2], l2[3], h2[0], h2[1], h2[2], h2[3]}, o[d0], 0, 0, 0);   \
        o[d0] = __builtin_amdgcn_mfma_f32_32x32x16_bf16(pa3, (bf16x8){l3[0], l3[1], l3[2], l3[3], h3[0], h3[1], h3[2], h3[3]}, o[d0], 0, 0, 0); } while (0)
    PV_D0(0); PV_D0(1); PV_D0(2); PV_D0(3);
#undef PV_D0
#undef TRRD
}
struct BlockRef { const bf16* Q; const bf16* K; const bf16* V; bf16* O; int P0; };
struct Seam { bf16x8 qr[8]; bf16x8 st_v0, st_v1, st_k0, st_k1; };
__device__ __forceinline__ __amdgpu_buffer_rsrc_t mk_rsrc(const void* p) { return __builtin_amdgcn_make_buffer_rsrc((void*)p, 0, SEQ * D * 2, 0x00020000); }
__device__ __forceinline__ bf16x8 bload(__amdgpu_buffer_rsrc_t r, int voff, int soff) { return __builtin_bit_cast(bf16x8, __builtin_amdgcn_raw_buffer_load_b128(r, voff, soff, 0)); }
#define VMW() asm volatile("s_waitcnt vmcnt(0)" ::: "memory")
#define VMWN(n) asm volatile("s_waitcnt vmcnt(%0)" :: "i"(n) : "memory")
#define SLOAD_H(Kp, Vp, k0) do { const __amdgpu_buffer_rsrc_t rk_ = mk_rsrc(Kp), rv_ = mk_rsrc(Vp); const int so_ = (k0) * (D * 2);                  \
                         S.st_v0 = bload(rv_, voff, so_); S.st_v1 = bload(rv_, voff, so_ + 32 * D * 2);              \
                         S.st_k0 = bload(rk_, voff, so_); S.st_k1 = bload(rk_, voff, so_ + 32 * D * 2); } while (0)
#define SWRITE_HK(bf) do { *(bf16x8*)(K_lds + (bf) * SHM_K + kws) = S.st_k0; *(bf16x8*)(K_lds + (bf) * SHM_K + kws + 32 * 256) = S.st_k1; } while (0)
#define SWRITE_HV(bf) do { *(bf16x8*)(V_lds + (bf) * SHM_V + vst0) = S.st_v0; *(bf16x8*)(V_lds + (bf) * SHM_V + vst1) = S.st_v1; } while (0)
#define SWRITE_H(bf) do { SWRITE_HV(bf); SWRITE_HK(bf); } while (0)
__device__ __forceinline__ void fox_prime(const BlockRef& cur, int j_lo, char* lds, Seam& S) {
    int tid = threadIdx.x; asm volatile("" : "+v"(tid));
    const int wid = __builtin_amdgcn_readfirstlane(tid >> 6), lane = tid & 63, r32 = lane & 31, hi = lane >> 5;
    const int sr = tid >> 4, sc = (tid & 15) * 8, kws = KSWZ(sr, sc * 2), voff = tid * 16; char* K_lds = lds + 2 * SHM_V;
    const int kb0 = j_lo * KVBLK;
    for (int d0 = 0; d0 < 8; ++d0) S.qr[d0] = load8(cur.Q + (size_t)(wid * QBLK + r32) * D + d0 * 16 + hi * 8);
    SLOAD_H(cur.K, cur.V, kb0); VMW(); SWRITE_HK(0);
    __syncthreads();
}
__device__ __forceinline__ void fox_block(const BlockRef& cur, const BlockRef& nxt, int j_lo, int jlo_n, char* lds, Seam& S) {
    int tid = threadIdx.x; asm volatile("" : "+v"(tid));
    const int wid = __builtin_amdgcn_readfirstlane(tid >> 6), lane = tid & 63, r32 = lane & 31, hi = lane >> 5;
    constexpr int W = SEQ, skv = SEQ;
    int j_hi = (cur.P0 + QB - 1) / KVBLK + 1; if (j_hi > skv / KVBLK) j_hi = skv / KVBLK;
    const int NT = j_hi - j_lo;
    const int kbn = jlo_n * KVBLK;
    const int qlo = cur.P0 + wid * QBLK, qm = qlo + r32 - 4 * hi;
    char* V_lds = lds; char* K_lds = lds + 2 * SHM_V;
    float* ws = (float*)(lds + 2 * SHM_V + 2 * SHM_K) + wid * 64; float* li_l = ws, * al_l = ws + 32;
    const float* ckb = (const float*)(lds + LDS_C) + 4 * hi;
    float m_reg = -1e30f, l_reg = 0; f32x16 o[4] = {};
    const int sr = tid >> 4, sc = (tid & 15) * 8, vst0 = v_st(sr, sc), vst1 = vst0 + 8192, kws = KSWZ(sr, sc * 2), voff = tid * 16;
    const int vb0 = (int)(uintptr_t)V_lds + v_rd_base(lane);
    const bf16* Kh = cur.K; const bf16* Vh = cur.V;
#define RESC(a) do { if (__any((a) < 1.f)) { if (hi == 0) al_l[r32] = (a); asm volatile("s_waitcnt lgkmcnt(0)" ::: "memory");              \
                     for (int d_ = 0; d_ < 4; ++d_) for (int r = 0; r < 16; ++r) o[d_][r] *= al_l[crow(r, hi)]; } } while (0)
#define KBASE(t) ((j_lo + (t)) * KVBLK)
#define MASKT(P0_, P1_, t) do { const int kb_ = KBASE(t); if (kb_ + KVBLK - 1 > qlo || kb_ <= qlo + QBLK - 1 - W) mask_tile(P0_, P1_, qm - kb_, (unsigned)W); } while (0)
    constexpr int NQL = 8;
#define SEAM_K0() do { VMWN(NQL); SWRITE_HK(0); SBAR(); } while (0)
    f32x16 pA0, pA1, pB0, pB1; float mnA, mnB, alA, alB; bf16x8 pa0, pa1, pa2, pa3;
    SWRITE_HV(0); SBAR();
    if (NT > 1) { SLOAD_H(Kh, Vh, KBASE(1)); }
    SBAR(); qkt<0>(pA0, pA1, K_lds, r32, hi, S.qr, ckb + KBASE(0));
    MASKT(pA0, pA1, 0); partialSM(pA0, pA1, m_reg, mnA, alA);
    if (NT > 1) { VMW(); SWRITE_H(1); }
    __syncthreads();
#define HALF_STEP(PX0, PX1, mnX, alX, PY0, PY1, alY, t, KB, VB, SB) do {                                                      \
        SBAR(); qkt<KB>(PX0, PX1, K_lds, r32, hi, S.qr, ckb + KBASE(t));                                                      \
        finishSM(PY0, PY1, alY, l_reg, pa0, pa1, pa2, pa3); SBAR();                                                           \
        if ((t) + 1 < NT) { SLOAD_H(Kh, Vh, KBASE((t) + 1)); SBAR(); }                                                        \
        pv_tile<VB>(o, vb0, pa0, pa1, pa2, pa3); MASKT(PX0, PX1, (t)); partialSM(PX0, PX1, m_reg, mnX, alX);                  \
        __syncthreads();                                                                                                      \
        if ((t) + 1 < NT) { VMW(); SWRITE_H(SB); }                                                                            \
        RESC(alX); __syncthreads(); } while (0)
    for (int t = 1; t + 1 < NT; t += 2) {
        HALF_STEP(pB0, pB1, mnB, alB, pA0, pA1, alA, t, 1, 0, 0);
        HALF_STEP(pA0, pA1, mnA, alA, pB0, pB1, alB, t + 1, 0, 1, 1);
    }
    const bool even = (NT & 1) == 0;
    if (even) { SBAR(); qkt<1>(pB0, pB1, K_lds, r32, hi, S.qr, ckb + KBASE(NT - 1)); SBAR(); }
    SLOAD_H(nxt.K, nxt.V, kbn); SBAR();
#pragma unroll
    for (int d0 = 0; d0 < 8; ++d0) S.qr[d0] = load8(nxt.Q + (size_t)(wid * QBLK + r32) * D + d0 * 16 + hi * 8);
    SBAR();
    finishSM(pA0, pA1, alA, l_reg, pa0, pa1, pa2, pa3); SBAR();
    pv_tile<0>(o, vb0, pa0, pa1, pa2, pa3);
    if (even) { MASKT(pB0, pB1, NT - 1); partialSM(pB0, pB1, m_reg, mnB, alB); __syncthreads(); RESC(alB);
        finishSM(pB0, pB1, alB, l_reg, pa0, pa1, pa2, pa3); SBAR(); pv_tile<1>(o, vb0, pa0, pa1, pa2, pa3); }
    SBAR(); SEAM_K0();
    if (hi == 0) li_l[r32] = l_reg; asm volatile("s_waitcnt lgkmcnt(0)" ::: "memory");
    float rli[16];
#pragma unroll
    for (int r = 0; r < 16; ++r) rli[r] = __builtin_amdgcn_rcpf(li_l[crow(r, hi)]);
    char* T = lds + LDS_C + wid * 4096;
    bf16* Ow = cur.O + (size_t)(wid * QBLK) * OP;
    int le = lane; asm volatile("" : "+v"(le));
    const int r32e = le & 31, hie = le >> 5, rrow = le >> 3, rch = le & 7, rd_off = rrow * 128 + ((rch ^ rrow) << 4);
#pragma unroll
    for (int p = 0; p < 2; ++p) {
#pragma unroll
        for (int r = 0; r < 16; ++r) { const int row = crow(r, hie), s0 = (r32e >> 3) ^ (row & 7);
            const unsigned w = cvtpk(o[2 * p][r] * rli[r], o[2 * p + 1][r] * rli[r]);
            *(unsigned short*)(T + row * 128 + (s0 << 4) + (r32e & 7) * 2) = (unsigned short)(w & 0xffffu);
            *(unsigned short*)(T + row * 128 + ((s0 ^ 4) << 4) + (r32e & 7) * 2) = (unsigned short)(w >> 16); }
        asm volatile("s_waitcnt lgkmcnt(0)" ::: "memory");
#pragma unroll
        for (int i = 0; i < 4; ++i) { const u32x4 v = *(const u32x4*)(T + i * 1024 + rd_off);
            *(u32x4*)(Ow + (size_t)(8 * i + rrow) * OP + p * 64 + rch * 8) = v; }
        asm volatile("s_waitcnt lgkmcnt(0)" ::: "memory");
    }
    __syncthreads();
#undef RESC
#undef KBASE
#undef MASKT
#undef SEAM_K0
#undef HALF_STEP
}
#undef VMW
#undef VMWN
#undef SLOAD_H
#undef SWRITE_HK
#undef SWRITE_HV
#undef SWRITE_H
constexpr float TSKIP = 20.0f * 11.313708498984761f;
__device__ __forceinline__ BlockRef fox_ref(int idx, const bf16* Q, const bf16* K, const bf16* V, bf16* O) {
    BlockRef r; const int bh = idx & 31, qb = 31 - (idx >> 5), b = bh >> 4, h = bh & 15;
    r.Q = Q + ((size_t)bh * SEQ + (size_t)qb * QB) * D; r.K = K + (size_t)bh * SEQ * D; r.V = V + (size_t)bh * SEQ * D;
    r.O = O + ((size_t)b * SEQ + (size_t)qb * QB) * OP + h * D; r.P0 = qb * QB; return r;
}
__device__ __forceinline__ int fox_jlo(const float* cpr, const float* qn, int idx) {
    int lane = threadIdx.x & 63; asm volatile("" : "+v"(lane));
    const int bh = idx & 31, qb = 31 - (idx >> 5), nfull = 4 * qb;
    const float* c = cpr + (size_t)bh * SEQ; const float* knh = qn + 65536 + bh * 128; const float* qp = qn + bh * 128 + 4 * qb;
    const float* dp = qn + 131072 + bh * 128 + 4 * qb;
    const float cq0 = c[qb * QB], Qn = fmaxf(fmaxf(qp[0], qp[1]), fmaxf(qp[2], qp[3])), dq = fminf(fminf(dp[0], dp[1]), fminf(dp[2], dp[3]));
    const float k0 = knh[lane], k1 = knh[64 + lane];
    bool keep0 = true, keep1 = true;
    if (lane < nfull) keep0 = !((cq0 - c[64 * lane + 63]) > Qn * k0 - dq + TSKIP);
    if (lane + 64 < nfull) keep1 = !((cq0 - c[64 * (lane + 64) + 63]) > Qn * k1 - dq + TSKIP);
    const unsigned long long b0 = __ballot(keep0), b1 = __ballot(keep1);
    const int jlo = b0 ? (__ffsll((long long)b0) - 1) : 64 + (__ffsll((long long)b1) - 1);
    return __builtin_amdgcn_readfirstlane(jlo);
}
__device__ __forceinline__ void fox_load_c(char* lds, const float* cpr, int idx, int j_lo) {
    const int bh = idx & 31, qb = 31 - (idx >> 5);
    const f32x4* src = (const f32x4*)(cpr + (size_t)bh * SEQ); f32x4* dst = (f32x4*)(lds + LDS_C);
    int t = threadIdx.x; asm volatile("" : "+v"(t));
    for (int i = j_lo * 16 + t; i < (qb + 1) * 64; i += 512) dst[i] = src[i];
}
__device__ __forceinline__ int fox_pop(unsigned* qctr, volatile LAS unsigned* slot) {
    if (threadIdx.x == 0) *slot = __hip_atomic_fetch_add(qctr, 1u, __ATOMIC_RELAXED, __HIP_MEMORY_SCOPE_AGENT);
    __syncthreads();
    const int v = (int)*slot;
    __syncthreads();
    return __builtin_amdgcn_readfirstlane(v);
}
__device__ __forceinline__ void fox_phase(char* lds, volatile LAS unsigned* slot, unsigned* qctr, const bf16* Q, const bf16* K, const bf16* V, bf16* O, const float* cpr, const float* qn) {
    int cur_i = fox_pop(qctr, slot); if (cur_i >= 1024) return;
    int jlo = fox_jlo(cpr, qn, cur_i);
    BlockRef cur = fox_ref(cur_i, Q, K, V, O);
    Seam S;
    fox_load_c(lds, cpr, cur_i, jlo);
    fox_prime(cur, jlo, lds, S);
    for (;;) {
        const int nxt_i = fox_pop(qctr, slot); const bool last = nxt_i >= 1024;
        const int jlo_n = last ? jlo : fox_jlo(cpr, qn, nxt_i);
        const BlockRef nxt = last ? cur : fox_ref(nxt_i, Q, K, V, O);
        fox_block(cur, nxt, jlo, jlo_n, lds, S);
        if (last) break;
        fox_load_c(lds, cpr, nxt_i, jlo_n); __syncthreads();
        cur = nxt; cur_i = nxt_i; jlo = jlo_n;
    }
}
#undef KSWZ
#undef SBAR
}

typedef GAS unsigned gu32;
#define RLX_AGENT __ATOMIC_RELAXED, __HIP_MEMORY_SCOPE_AGENT
#define XB_TMO      128
#define XB_XCNT(j)  (256  + 64 * (j))
#define XB_XSUB(j)  (1280 + 64 * (j))
#define XB_XGEN(j)  (2304 + 64 * (j))
#define XB_TOP      3328
#define XB_TOPGEN   3392
#define XCD_BAR_WORDS 3456
#define XB_SPIN_CAP (1u << 18)
__device__ __forceinline__ unsigned xb_ld(unsigned* p)              { return __hip_atomic_load(p, __ATOMIC_RELAXED, __HIP_MEMORY_SCOPE_AGENT); }
__device__ __forceinline__ unsigned xb_add(unsigned* p, unsigned v) { return __hip_atomic_fetch_add(p, v, __ATOMIC_RELAXED, __HIP_MEMORY_SCOPE_AGENT); }
__device__ __forceinline__ unsigned xb_xcc_id() { return (unsigned)__builtin_amdgcn_s_getreg((3 << 11) | 20) & 0xFu; }
#define XB_SPIN(cond, bar) do { unsigned _sp = 0; while (cond) { __builtin_amdgcn_s_sleep(1); \
    if ((++_sp & 255u) == 0u) { if (xb_ld(&(bar)[XB_TMO])) break; if (_sp > XB_SPIN_CAP) { atomicAdd(&(bar)[XB_TMO], 1u); break; } } } } while (0)
struct XcdBarrier { unsigned* bar; unsigned x; volatile LAS unsigned* st; };
__device__ __forceinline__ XcdBarrier xcd_barrier_post(unsigned* bar, volatile LAS unsigned* st) {
    XcdBarrier b; b.bar = bar; b.x = xb_xcc_id(); b.st = st;
    if (threadIdx.x == 0) (void)xb_add(&bar[XB_XCNT(b.x)], 1u);
    return b;
}
__device__ __forceinline__ void xcd_barrier_complete(unsigned* bar, unsigned x, unsigned& nloc, unsigned& nx) {
    const unsigned G = gridDim.x * gridDim.y * gridDim.z;
    unsigned sum, cnt, mine, sp = 0u;
    for (;;) {
        sum = 0u; cnt = 0u; mine = 0u;
#pragma unroll
        for (unsigned j = 0; j < 16; ++j) { const unsigned c = xb_ld(&bar[XB_XCNT(j)]); sum += c; cnt += (c > 0u) ? 1u : 0u; mine = (j == x) ? c : mine; }
        if (sum == G) break;
        __builtin_amdgcn_s_sleep(1);
        if ((++sp & 255u) == 0u) { if (xb_ld(&bar[XB_TMO])) break; if (sp > XB_SPIN_CAP) { atomicAdd(&bar[XB_TMO], 1u); break; } }
    }
    nloc = mine > 0u ? mine : 1u; nx = cnt > 0u ? cnt : 1u;
}
__device__ __forceinline__ void xcd_barrier(const XcdBarrier& b) {
    asm volatile("s_waitcnt vmcnt(0)" ::: "memory");
    __syncthreads();
    if (threadIdx.x == 0) {
        unsigned* bar = b.bar;
        __builtin_amdgcn_s_waitcnt(0);
        unsigned nloc = b.st[0], nx = b.st[1];
        if (nloc == 0u) { xcd_barrier_complete(bar, b.x, nloc, nx); b.st[0] = nloc; b.st[1] = nx; }
        const unsigned old = xb_add(&bar[XB_XSUB(b.x)], 1u);
        const unsigned gen = old / nloc;
        if (old + 1u == (gen + 1u) * nloc) {
            __builtin_amdgcn_fence(__ATOMIC_RELEASE, "agent");
            asm volatile("s_waitcnt vmcnt(0)" ::: "memory");
            const unsigned og = xb_add(&bar[XB_TOP], 1u);
            const unsigned tg = og / nx;
            if (og + 1u == (tg + 1u) * nx) xb_add(&bar[XB_TOPGEN], 1u);
            else XB_SPIN(xb_ld(&bar[XB_TOPGEN]) == tg, bar);
            __builtin_amdgcn_fence(__ATOMIC_ACQUIRE, "agent");
            xb_add(&bar[XB_XGEN(b.x)], 1u);
            asm volatile("s_waitcnt vmcnt(0)" ::: "memory");
        } else {
            XB_SPIN(xb_ld(&bar[XB_XGEN(b.x)]) == gen, bar);
            __builtin_amdgcn_fence(__ATOMIC_ACQUIRE, "agent");
            asm volatile("s_waitcnt vmcnt(0)" ::: "memory");
        }
    }
    __syncthreads();
}

__device__ __forceinline__ void p0_transpose_item(const float* W, int ldn, int col0, int nblk, int nvalid, int K, const float* gain, bf16_t* WT, int row_off, LAS float* scr, int item, int lane) {
    const int kb = item / nblk, nb = item - kb * nblk, k0 = 64 * kb, n0 = 32 * nb, rr = lane >> 3, c4 = (lane & 7) * 4;
    f32x4 v[8];
#pragma unroll
    for (int i = 0; i < 8; ++i) v[i] = (c4 < nvalid) ? *(const GAS f32x4*)(W + (size_t)(k0 + 8 * i + rr) * ldn + col0 + n0 + c4) : (f32x4){0.f, 0.f, 0.f, 0.f};
#pragma unroll
    for (int i = 0; i < 8; ++i) { const int kk = 8 * i + rr; f32x4 w = v[i]; if (gain) w = w * gain[k0 + kk];
        LAS float* d = scr + kk * 33 + c4; d[0] = w[0]; d[1] = w[1]; d[2] = w[2]; d[3] = w[3]; }
    LDS_WAIT(); asm volatile("" ::: "memory");
    const int c = lane & 7;
#pragma unroll
    for (int j = 0; j < 4; ++j) { const int n = (lane >> 3) + 8 * j; const LAS float* s = scr + (8 * c) * 33 + n;
        u32x4 o; o.x = cvt_pk_bf16(s[0 * 33], s[1 * 33]); o.y = cvt_pk_bf16(s[2 * 33], s[3 * 33]); o.z = cvt_pk_bf16(s[4 * 33], s[5 * 33]); o.w = cvt_pk_bf16(s[6 * 33], s[7 * 33]);
        if (n < nvalid) *(GAS u32x4*)(WT + (size_t)(row_off + n0 + n) * K + k0 + 8 * c) = o; }
    LDS_WAIT(); asm volatile("" ::: "memory");
}
template <bool I8> __device__ __forceinline__ void p0_transpose_item_8(const float* W, int ldn, int col0, int nblk, int K, float wscale, const float* gain, unsigned char* WT8, int row_off, LAS float* scr, int item, int lane) {
    const int kb = item / nblk, nb = item - kb * nblk, k0 = 64 * kb, n0 = 32 * nb, rr = lane >> 3, c4 = (lane & 7) * 4;
    f32x4 v[8];
#pragma unroll
    for (int i = 0; i < 8; ++i) v[i] = *(const GAS f32x4*)(W + (size_t)(k0 + 8 * i + rr) * ldn + col0 + n0 + c4);
#pragma unroll
    for (int i = 0; i < 8; ++i) { const int kk = 8 * i + rr; const f32x4 w = v[i] * (gain ? wscale * gain[k0 + kk] : wscale); LAS float* d = scr + kk * 33 + c4; d[0] = w[0]; d[1] = w[1]; d[2] = w[2]; d[3] = w[3]; }
    LDS_WAIT(); asm volatile("" ::: "memory");
    const int c = lane & 7;
#pragma unroll
    for (int j = 0; j < 4; ++j) { const int n = (lane >> 3) + 8 * j; const LAS float* s = scr + (8 * c) * 33 + n;
        u32x2 o; if constexpr (I8) { o.x = pk4_i8(s[0 * 33], s[1 * 33], s[2 * 33], s[3 * 33]); o.y = pk4_i8(s[4 * 33], s[5 * 33], s[6 * 33], s[7 * 33]); }
        else { o.x = pk4_fp8(s[0 * 33], s[1 * 33], s[2 * 33], s[3 * 33]); o.y = pk4_fp8(s[4 * 33], s[5 * 33], s[6 * 33], s[7 * 33]); }
        *(GAS u32x2*)(WT8 + (size_t)(row_off + n0 + n) * K + k0 + 8 * c) = o; }
    LDS_WAIT(); asm volatile("" ::: "memory");
}
__device__ __forceinline__ void p0_transpose_item64(const float* W, int ldn, int col0, int nblk, int K, const float* gain, bf16_t* WT, int row_off, LAS float* scr, int item, int lane) {
    const int kb = item / nblk, nb = item - kb * nblk, k0 = 64 * kb, n0 = 64 * nb, rr = lane >> 3, c4 = (lane & 7) * 4, c = lane & 7;
    f32x4 v[2][8];
#pragma unroll
    for (int i = 0; i < 8; ++i) { const GAS f32x4* sp = (const GAS f32x4*)(W + (size_t)(k0 + 8 * i + rr) * ldn + col0 + n0 + c4); v[0][i] = sp[0]; v[1][i] = sp[8]; }
#pragma unroll
    for (int h = 0; h < 2; ++h) {
#pragma unroll
        for (int i = 0; i < 8; ++i) { const int kk = 8 * i + rr; f32x4 w = v[h][i]; if (gain) w = w * gain[k0 + kk];
            LAS float* d = scr + kk * 33 + c4; d[0] = w[0]; d[1] = w[1]; d[2] = w[2]; d[3] = w[3]; }
        LDS_WAIT(); asm volatile("" ::: "memory");
#pragma unroll
        for (int j = 0; j < 4; ++j) { const int n = (lane >> 3) + 8 * j; const LAS float* s = scr + (8 * c) * 33 + n;
            u32x4 o; o.x = cvt_pk_bf16(s[0 * 33], s[1 * 33]); o.y = cvt_pk_bf16(s[2 * 33], s[3 * 33]); o.z = cvt_pk_bf16(s[4 * 33], s[5 * 33]); o.w = cvt_pk_bf16(s[6 * 33], s[7 * 33]);
            *(GAS u32x4*)(WT + (size_t)(row_off + n0 + 32 * h + n) * K + k0 + 8 * c) = o; }
        LDS_WAIT(); asm volatile("" ::: "memory");
    }
}
template <bool I8> __device__ __forceinline__ void p0_transpose_item64_8(const float* W, int ldn, int col0, int nblk, int K, float wscale, const float* gain, unsigned char* WT8, int row_off, LAS float* scr, int item, int lane) {
    const int kb = item / nblk, nb = item - kb * nblk, k0 = 64 * kb, n0 = 64 * nb, rr = lane >> 3, c4 = (lane & 7) * 4, c = lane & 7;
    f32x4 v[2][8];
#pragma unroll
    for (int i = 0; i < 8; ++i) { const GAS f32x4* sp = (const GAS f32x4*)(W + (size_t)(k0 + 8 * i + rr) * ldn + col0 + n0 + c4); v[0][i] = sp[0]; v[1][i] = sp[8]; }
#pragma unroll
    for (int h = 0; h < 2; ++h) {
#pragma unroll
        for (int i = 0; i < 8; ++i) { const int kk = 8 * i + rr; const f32x4 w = v[h][i] * (gain ? wscale * gain[k0 + kk] : wscale); LAS float* d = scr + kk * 33 + c4; d[0] = w[0]; d[1] = w[1]; d[2] = w[2]; d[3] = w[3]; }
        LDS_WAIT(); asm volatile("" ::: "memory");
#pragma unroll
        for (int j = 0; j < 4; ++j) { const int n = (lane >> 3) + 8 * j; const LAS float* s = scr + (8 * c) * 33 + n;
            u32x2 o; if constexpr (I8) { o.x = pk4_i8(s[0 * 33], s[1 * 33], s[2 * 33], s[3 * 33]); o.y = pk4_i8(s[4 * 33], s[5 * 33], s[6 * 33], s[7 * 33]); }
            else { o.x = pk4_fp8(s[0 * 33], s[1 * 33], s[2 * 33], s[3 * 33]); o.y = pk4_fp8(s[4 * 33], s[5 * 33], s[6 * 33], s[7 * 33]); }
            *(GAS u32x2*)(WT8 + (size_t)(row_off + n0 + 32 * h + n) * K + k0 + 8 * c) = o; }
        LDS_WAIT(); asm volatile("" ::: "memory");
    }
}
__device__ __forceinline__ void rms_row_to_bf16(const float* xrow, const float* gain, bf16_t* orow, unsigned char* orow8, int lane) {
    const GAS f32x4* xr = (const GAS f32x4*)xrow + lane; const GAS f32x4* gr = (const GAS f32x4*)gain + lane;
    f32x4 v[16]; float s = 0.f;
#pragma unroll
    for (int j = 0; j < 16; ++j) { v[j] = xr[64 * j]; s += (v[j].x * v[j].x + v[j].y * v[j].y) + (v[j].z * v[j].z + v[j].w * v[j].w); }
    const float r = 1.0f / sqrtf(wave_sum(s) * (1.0f / DM) + EPS);
    GAS u32x2* o8 = (GAS u32x2*)orow + lane;
#pragma unroll
    for (int j = 0; j < 16; ++j) { const f32x4 g = gr[64 * j]; const float a = v[j].x * r * g.x, b = v[j].y * r * g.y, c = v[j].z * r * g.z, d = v[j].w * r * g.w;
        u32x2 w; w.x = cvt_pk_bf16(a, b); w.y = cvt_pk_bf16(c, d); o8[64 * j] = w;
        if (orow8) ((GAS unsigned*)orow8)[lane + 64 * j] = pk4_i8(a * S_H, b * S_H, c * S_H, d * S_H); }
}
__device__ __forceinline__ void rms_rows2_to_bf16(const float* xb, const float* gain, bf16_t* ob, unsigned char* ob8, int m, int rstep, int lane) {
    const GAS f32x4* gr = (const GAS f32x4*)gain + lane;
    f32x4 v[2][16];
#pragma unroll
    for (int q = 0; q < 2; ++q) { const GAS f32x4* xr = (const GAS f32x4*)(xb + (size_t)(m + q * rstep) * DM) + lane;
#pragma unroll
        for (int j = 0; j < 16; ++j) v[q][j] = xr[64 * j]; }
#pragma unroll
    for (int q = 0; q < 2; ++q) { const size_t ro = (size_t)(m + q * rstep) * DM; float s = 0.f;
#pragma unroll
        for (int j = 0; j < 16; ++j) s += (v[q][j].x * v[q][j].x + v[q][j].y * v[q][j].y) + (v[q][j].z * v[q][j].z + v[q][j].w * v[q][j].w);
        const float r = 1.0f / sqrtf(wave_sum(s) * (1.0f / DM) + EPS);
        GAS u32x2* o8 = (GAS u32x2*)(ob + ro) + lane;
#pragma unroll
        for (int j = 0; j < 16; ++j) { const f32x4 g = gr[64 * j]; const float a = v[q][j].x * r * g.x, b = v[q][j].y * r * g.y, c = v[q][j].z * r * g.z, d = v[q][j].w * r * g.w;
            u32x2 w; w.x = cvt_pk_bf16(a, b); w.y = cvt_pk_bf16(c, d); o8[64 * j] = w;
            ((GAS unsigned*)(ob8 + ro))[lane + 64 * j] = pk4_i8(a * S_H, b * S_H, c * S_H, d * S_H); } }
}
template <int NC, int R> __device__ __forceinline__ void quant_rows_i8(const bf16_t* src, unsigned char* dst, float* dq, int row0, int rstep, int lane) {
    constexpr int NJ = NC / 512; u32x4 w[R][NJ];
#pragma unroll
    for (int r = 0; r < R; ++r)
#pragma unroll
        for (int j = 0; j < NJ; ++j) w[r][j] = *(const GAS u32x4*)(src + (size_t)(row0 + r * rstep) * NC + (size_t)(j * 64 + lane) * 8);
#pragma unroll
    for (int r = 0; r < R; ++r) { const int row = row0 + r * rstep; float mx = 0.f;
#pragma unroll
        for (int j = 0; j < NJ; ++j) { f32x4 a, b; unpack8f(w[r][j], a, b);
#pragma unroll
            for (int i = 0; i < 4; ++i) mx = fmaxf(mx, fmaxf(fabsf(a[i]), fabsf(b[i]))); }
#pragma unroll
        for (int o = 1; o < 64; o <<= 1) mx = fmaxf(mx, __shfl_xor(mx, o));
        const float sc = 127.0f / fmaxf(mx, 1e-20f);
#pragma unroll
        for (int j = 0; j < NJ; ++j) { f32x4 a, b; unpack8f(w[r][j], a, b); a = a * sc; b = b * sc; u32x2 o; o.x = pk4_i8(a[0], a[1], a[2], a[3]); o.y = pk4_i8(b[0], b[1], b[2], b[3]);
            *(GAS u32x2*)(dst + (size_t)row * NC + (size_t)(j * 64 + lane) * 8) = o; }
        if (lane == 0) dq[row] = mx * (1.0f / 127.0f); }
}
__device__ __forceinline__ void s5_pow(float dt, float are, float aim, float k, float& wr, float& wi) {
    const float mag = __builtin_amdgcn_exp2f(k * dt * are * 1.4426950408889634f);
    double rev = (double)k * (double)dt * (double)aim * 0.15915494309189535; rev -= floor(rev);
    const float rf = (float)rev;
    wr = mag * __builtin_amdgcn_cosf(rf); wi = mag * __builtin_amdgcn_sinf(rf);
}
__device__ __forceinline__ void s5_f(float dt, float are, float aim, float& fre, float& fim) {
    float lr, li; s5_pow(dt, are, aim, 1.f, lr, li);
    const float den = are * are + aim * aim, nr = lr - 1.0f, ni = li;
    fre = (nr * are + ni * aim) / den; fim = (ni * are - nr * aim) / den;
}

constexpr int RSTD_OFF = RING_BYTES + 1024;
__device__ __forceinline__ void build_rstd_table(LAS unsigned char* lds, const float* ss, int pm0, float scale) {
    LAS float* rs = (LAS float*)(lds + RSTD_OFF); const int tid = threadIdx.x, r = tid >> 1, hf = tid & 1;
    const f32x4* p = (const f32x4*)(ss + ((size_t)pm0 * 256 + r) * 64 + hf * 32); float s = 0.f;
#pragma unroll
    for (int i = 0; i < 8; ++i) { const f32x4 a = p[i]; s += (a[0] + a[1]) + (a[2] + a[3]); }
    s += __shfl_xor(s, 1);
    if (hf == 0) rs[r] = scale / sqrtf(s * (1.0f / DM) + EPS);
    LDS_WAIT(); __syncthreads();
}
constexpr int NPH = 14;
struct Args { const float* in[29]; float* out; unsigned char* ws; int ph_lo, ph_hi, li, zero; };
enum { I_X = 0, I_MEM, I_GMIX, I_WIN, I_BF, I_BGATE, I_ARE, I_AIM, I_LOGDT, I_BRE, I_BIM, I_CRE, I_CIM, I_DSKIP, I_WGLU, I_BGLU, I_WAU, I_WSU, I_WOUT, I_GX, I_GMEM, I_WQ, I_WK, I_WV, I_WO, I_GMLP, I_FF1, I_FF2, I_GFIN };

__global__ void __launch_bounds__(NWAVES * 64, 2) fwd_kernel(Args args) {
    extern __shared__ __attribute__((aligned(16))) unsigned char lds_raw[];
    LAS unsigned char* lds = (LAS unsigned char*)lds_raw;
    volatile LAS unsigned* MISC = (volatile LAS unsigned*)(lds + MISC_OFF);
    const int tid = threadIdx.x, lane = tid & 63, wave = __builtin_amdgcn_readfirstlane(tid >> 6);
    const int G = gridDim.x, cb = blockIdx.x;
    const int gw = cb * NWAVES + wave, NGW = G * NWAVES;
    unsigned char* ws = args.ws;
    gu32* ctl = (gu32*)(ws + WS_CTL);
    for (int u = tid; u < (LDS_BYTES - LDSCTL_OFF) / 4; u += NWAVES * 64) ((LAS unsigned*)(lds + LDSCTL_OFF))[u] = 0u;
    __syncthreads();
    XcdBarrier bar; bar.bar = (unsigned*)(ctl + CW_BAR); bar.x = 0; bar.st = nullptr;
    if (MK_N_LAUNCHES == 1) bar = xcd_barrier_post((unsigned*)(ctl + CW_BAR), MISC + 8);
    const int lo = args.ph_lo, hi = args.ph_hi, ZR = args.zero;
#ifndef PH_MASK
#define PH_MASK 0x3fff
#endif
#define IN(k) ((((PH_MASK) >> (k)) & 1) && lo <= (k) && (k) < hi)
#define BOTH(k) (IN(k) && IN((k) + 1))
#define GRID_BAR() do { xcd_barrier(bar); } while (0)

    const float* x = args.in[I_X]; float* out = args.out;
#define XB ((bf16_t*)(ws + WS_XB))
#define WIN ((bf16_t*)(ws + WS_WIN))
#define FF1 ((bf16_t*)(ws + WS_FF1))
#define FF2 ((bf16_t*)(ws + WS_FF2))
#define WOUT ((bf16_t*)(ws + WS_WOUT))
#define WAU ((bf16_t*)(ws + WS_WAU))
#define WSU ((bf16_t*)(ws + WS_WSU))
#define WGLU ((bf16_t*)(ws + WS_WGLU))
#define WQ ((bf16_t*)(ws + WS_WQ))
#define WK ((bf16_t*)(ws + WS_WK))
#define WV ((bf16_t*)(ws + WS_WV))
#define WO ((bf16_t*)(ws + WS_WO))
#define MN ((bf16_t*)(ws + WS_MN))
#define Qb ((bf16_t*)(ws + WS_Q))
#define Kb ((bf16_t*)(ws + WS_K))
#define Vb ((bf16_t*)(ws + WS_V))
#define UG ((bf16_t*)(ws + WS_UG))
#define KT ((bf16_t*)(ws + WS_KT))
#define WEND ((bf16_t*)(ws + WS_WEND))
#define GATES ((unsigned char*)(ws + WS_GATES))
#define Ob ((bf16_t*)(ws + WS_O))
#define Yb ((bf16_t*)(ws + WS_Y))
#define Y2b ((bf16_t*)(ws + WS_Y2))
#define MERGED ((bf16_t*)(ws + WS_MERGED))
#define MERGED2 ((bf16_t*)(ws + WS_Q))
#define QX ((bf16_t*)(ws + WS_QX))
#define PX ((bf16_t*)(ws + WS_PX))
#define OX ((bf16_t*)(ws + WS_OX))
#define HID ((bf16_t*)(ws + WS_HID))
#define KXB ((bf16_t*)(ws + WS_KXB))
#define VXTB ((bf16_t*)(ws + WS_VXTB))
#define LOGF ((float*)(ws + WS_LOGF))
#define CPR ((float*)(ws + WS_CPR))
#define KERN ((float*)(ws + WS_KERN))
#define LB32 ((float*)(ws + WS_LB32))
#define SS1 ((float*)(ws + WS_SS1))
#define SS2 ((float*)(ws + WS_SS2))
#define SS3 ((float*)(ws + WS_SS3))
#define KS ((float*)(ws + WS_KS))
#define VS ((float*)(ws + WS_VS))
#define H8 ((unsigned char*)(args.out))
#define X8 ((unsigned char*)(args.out))
#define WQ8 ((unsigned char*)args.out + 96 * MiB)
#define WO8 ((unsigned char*)args.out + 100 * MiB)
#define OX8 ((unsigned char*)args.out + 104 * MiB)
#define W8 ((unsigned char*)args.out + 120 * MiB)
#define O8 ((unsigned char*)args.out + 64 * MiB)
#define M8 ((unsigned char*)args.out + 148 * MiB)
#define SO ((float*)(ws + WS_LB32 + 64 * 1024))
#define SM ((float*)(ws + WS_LB32 + 128 * 1024))
#define QN ((float*)(ws + WS_LB32 + 256 * 1024))
#define KN ((float*)(ws + WS_LB32 + 512 * 1024))
#define DMN ((float*)(ws + WS_LB32 + 768 * 1024))
    if (IN(0)) {
        LAS float* scr = (LAS float*)(lds + wave * 16384);
        {
            constexpr int I0 = (DM / 64) * (6144 / 64), I1 = (DM / 64) * (SW / 64), I2 = (DM / 64) * (8192 / 64), I3 = (DM / 64) * 1;
            constexpr int NITEMS = I0 + I1 + I2 + I3;
            for (int it = gw; it < NITEMS; it += NGW) {
                int r = it;
                if (r < I0) { p0_transpose_item64_8<true>(args.in[I_WIN], INW, 0, 6144 / 64, DM, S_W, nullptr, W8, 0, scr, r, lane); continue; } r -= I0;
                if (r < I1) { p0_transpose_item64_8<true>(args.in[I_WIN], INW, OFF_U, SW / 64, DM, S_W, nullptr, W8, 6144, scr, r, lane); continue; } r -= I1;
                if (r < I2) { p0_transpose_item64_8<true>(args.in[I_WIN], INW, OFF_G, 8192 / 64, DM, S_W, nullptr, W8, 7168, scr, r, lane); continue; } r -= I2;
                p0_transpose_item(args.in[I_WIN], INW, OFF_F, 1, 16, DM, nullptr, WIN, WIN_F, scr, r, lane);
            }
        }
        if (G == 256) { for (int m = gw; m < M; m += 2 * NGW) rms_rows2_to_bf16(x, args.in[I_GMIX], XB, H8, m, NGW, lane); }
        else { for (int m = gw; m < M; m += NGW) rms_row_to_bf16(x + (size_t)m * DM, args.in[I_GMIX], XB + (size_t)m * DM, H8 + (size_t)m * DM, lane); }
        for (int m = gw; m < BATCH * MEML; m += NGW) rms_row_to_bf16(args.in[I_MEM] + (size_t)m * DM, args.in[I_GMEM], MN + (size_t)m * DM, nullptr, lane);
        for (int it = gw; it < SG * CT; it += NGW) {
            const int g = it / CT, tau = it - g * CT, p = lane;
            const float dt = __builtin_amdgcn_exp2f(args.in[I_LOGDT][g] * 1.4426950408889634f), are = args.in[I_ARE][g * SP + p], aim = args.in[I_AIM][g * SP + p];
            float fre, fim, wr, wi; s5_f(dt, are, aim, fre, fim); s5_pow(dt, are, aim, (float)tau, wr, wi);
#pragma unroll
            for (int h = 0; h < SGC; ++h) { const float br = args.in[I_BRE][(g * SP + p) * SGC + h], bi = args.in[I_BIM][(g * SP + p) * SGC + h];
                const float bbr = fre * br - fim * bi, bbi = fre * bi + fim * br;
                scr[p * 17 + h] = wr * bbr - wi * bbi; scr[64 * 17 + p * 17 + h] = wr * bbi + wi * bbr; }
            LDS_WAIT(); asm volatile("" ::: "memory");
            const int h = lane >> 2, hb = (lane & 3) * 4; f32x4 acc4 = {0.f, 0.f, 0.f, 0.f};
            for (int pp = 0; pp < SP; ++pp) { const float cr = args.in[I_CRE][(g * SGC + h) * SP + pp], ci = args.in[I_CIM][(g * SGC + h) * SP + pp];
#pragma unroll
                for (int j = 0; j < 4; ++j) acc4[j] += cr * scr[pp * 17 + hb + j] - ci * scr[64 * 17 + pp * 17 + hb + j]; }
            if (tau == 0) {
#pragma unroll
                for (int j = 0; j < 4; ++j) if (hb + j == h) acc4[j] += args.in[I_DSKIP][g * SGC + h]; }
            *(f32x4*)(KERN + ((size_t)(g * CT + tau) * 256 + lane * 4)) = acc4;
            LDS_WAIT(); asm volatile("" ::: "memory");
        }
        for (int it = gw; it < SG * SP; it += NGW) {
            const int g = it >> 6, p = it & 63, s = lane >> 1, hb = (lane & 1) * 8;
            const float dt = __builtin_amdgcn_exp2f(args.in[I_LOGDT][g] * 1.4426950408889634f), are = args.in[I_ARE][g * SP + p], aim = args.in[I_AIM][g * SP + p];
            float fre, fim, wr, wi; s5_f(dt, are, aim, fre, fim); s5_pow(dt, are, aim, (float)(CT - 1 - s), wr, wi);
            const float gr = wr * fre - wi * fim, gi = wr * fim + wi * fre;
            f32x4 re[2], im[2];
#pragma unroll
            for (int j = 0; j < 8; ++j) { const float br = args.in[I_BRE][(g * SP + p) * SGC + hb + j], bi = args.in[I_BIM][(g * SP + p) * SGC + hb + j];
                re[j >> 2][j & 3] = gr * br - gi * bi; im[j >> 2][j & 3] = gr * bi + gi * br; }
            *(u32x4*)(WEND + ((size_t)g * 256 + p) * 512 + s * SGC + hb) = pack8f(re[0], re[1]);
            *(u32x4*)(WEND + ((size_t)g * 256 + 64 + p) * 512 + s * SGC + hb) = pack8f(im[0], im[1]);
        }
        for (int q = cb * 512 + tid; q < SG * 8192; q += G * 512) { const int g = q >> 13, r = q & 8191; *(u32x4*)(WEND + ((size_t)g * 256 + 128) * 512 + (size_t)r * 8) = (u32x4){0u, 0u, 0u, 0u}; }
        for (int it = gw; it < SG * CT; it += NGW) {
            const int g = it / CT, t = it - g * CT, p = lane;
            const float dt = __builtin_amdgcn_exp2f(args.in[I_LOGDT][g] * 1.4426950408889634f), are = args.in[I_ARE][g * SP + p], aim = args.in[I_AIM][g * SP + p];
            float wr, wi; s5_pow(dt, are, aim, (float)(t + 1), wr, wi);
#pragma unroll
            for (int h = 0; h < SGC; ++h) { const float cr = args.in[I_CRE][(g * SGC + h) * SP + p], ci = args.in[I_CIM][(g * SGC + h) * SP + p];
                bf16_t* rowp = KT + ((size_t)g * UR + t * SGC + h) * UK + CT * SGC;
                rowp[p] = (bf16_t)(cvt_pk_bf16(cr * wr - ci * wi, 0.f) & 0xffffu); rowp[SP + p] = (bf16_t)(cvt_pk_bf16(-(cr * wi + ci * wr), 0.f) & 0xffffu); }
        }
        for (int it = gw; it < SG; it += NGW) { const int g = it, p = lane;
            const float dt = __builtin_amdgcn_exp2f(args.in[I_LOGDT][g] * 1.4426950408889634f), are = args.in[I_ARE][g * SP + p], aim = args.in[I_AIM][g * SP + p];
            float wr, wi; s5_pow(dt, are, aim, (float)CT, wr, wi); LB32[(g * SP + p) * 2] = wr; LB32[(g * SP + p) * 2 + 1] = wi; }
        if (BOTH(0)) GRID_BAR();
    }

    if (IN(1)) {
        for (int it = gw; it < SG * CT; it += NGW) {
            const int g = it / CT, t = it - g * CT;
#pragma unroll 4
            for (int i = 0; i < 16; ++i) { const int q = i * 64 + lane, h = q >> 6, s = (q >> 1) & 31, half = q & 1;
                u32x4 w = {0u, 0u, 0u, 0u};
                if (s <= t) { const f32x4* src = (const f32x4*)(KERN + ((size_t)(g * CT + (t - s)) * SGC + h) * SGC + half * 8); w = pack8f(src[0], src[1]); }
                *(u32x4*)(KT + ((size_t)g * UR + t * SGC + h) * UK + s * SGC + half * 8) = w; }
        }
        if (cb < G - NCONV) { pg8::Gemm g{DM / 2, DM / 2, DM / 2 + ZR}; pg8::PlainOrder S; S.init((const bf16_t*)H8, (const bf16_t*)W8, DM / 2, DM / 2, M, 15360, G - NCONV, cb);
          pg8::EpiProjGates E{{Qb, UG, 1.0f / (S_H * S_W)}, {GATES, args.in[I_BGATE], 1.0f / (S_H * S_W)}};
          pg8::gemm_phase<pg8::EpiProjGates, pg8::PlainOrder, true, 2>(lds, g, S, E); }
        __syncthreads();
        {
            constexpr int I4 = (SW / 64) * (SW / 64), I5 = (AW / 64) * (DM / 64), I6 = (SW / 64) * (DM / 64), I7 = (DM / 64) * (DM / 64);
            constexpr int I8 = (DM / 64) * (XW / 64), I11 = (XW / 64) * (DM / 64), I12 = (DM / 64) * (DFF / 64), I13 = (DFF / 64) * (DM / 64);
            constexpr int NDEF = I4 + I5 + I6 + I7 + 3 * I8 + I11 + I12 + I13;
            LAS float* scr = (LAS float*)(lds + wave * 16384);
            int ln = lane; asm volatile("" : "+v"(ln));
            for (;;) {
                int base = 0; if (ln == 0) base = (int)__hip_atomic_fetch_add((unsigned*)(ctl + CW_CONVQ), (unsigned)CONVCH, __ATOMIC_RELAXED, __HIP_MEMORY_SCOPE_AGENT); base = __builtin_amdgcn_readfirstlane(base);
                if (base >= NDEF) break;
              for (int j = 0; j < CONVCH; ++j) {
                int r = base + j; if (r >= NDEF) break;
                if (r < I12) { p0_transpose_item64(args.in[I_FF1], DFF, 0, DFF / 64, DM, args.in[I_GMLP], FF1, 0, scr, r, ln); continue; } r -= I12;
                if (r < I13) { p0_transpose_item64(args.in[I_FF2], DM, 0, DM / 64, DFF, nullptr, FF2, 0, scr, r, ln); continue; } r -= I13;
                if (r < I7) { p0_transpose_item64_8<true>(args.in[I_WOUT], DM, 0, DM / 64, DM, S_W, nullptr, (unsigned char*)WOUT, 0, scr, r, ln); continue; } r -= I7;
                if (r < I5) { p0_transpose_item64_8<true>(args.in[I_WAU], DM, 0, DM / 64, AW, S_WAU, nullptr, (unsigned char*)WAU, 0, scr, r, ln); continue; } r -= I5;
                if (r < I6) { p0_transpose_item64(args.in[I_WSU], DM, 0, DM / 64, SW, nullptr, WSU, 0, scr, r, ln); continue; } r -= I6;
                if (r < I4) { p0_transpose_item64(args.in[I_WGLU], SW, 0, SW / 64, SW, nullptr, WGLU, 0, scr, r, ln); continue; } r -= I4;
                if (r < I8) { p0_transpose_item64_8<true>(args.in[I_WQ], XW, 0, XW / 64, DM, S_W, args.in[I_GX], WQ8, 0, scr, r, ln); continue; } r -= I8;
                if (r < I8) { p0_transpose_item64(args.in[I_WK], XW, 0, XW / 64, DM, nullptr, WK, 0, scr, r, ln); continue; } r -= I8;
                if (r < I8) { p0_transpose_item64(args.in[I_WV], XW, 0, XW / 64, DM, nullptr, WV, 0, scr, r, ln); continue; } r -= I8;
                p0_transpose_item64_8<false>(args.in[I_WO], DM, 0, DM / 64, XW, 256.0f, nullptr, WO8, 0, scr, r, ln);
              }
            }
        }
        __syncthreads();
        int ln = lane; asm volatile("" : "+v"(ln));
        for (int it0 = cb * 4; it0 < M / 16; it0 += G * 4) {
            const int it = it0 + (wave & 3), kh = wave >> 2, r = ln & 15, q = ln >> 4;
            const bf16_t* ap = XB + (size_t)(it * 16 + r) * DM + kh * (DM / 2) + q * 8; const bf16_t* bp = WIN + (size_t)(WIN_F + r) * DM + kh * (DM / 2) + q * 8;
            f32x4 a4 = {0.f, 0.f, 0.f, 0.f};
#pragma unroll 16
            for (int k0 = 0; k0 < DM / 2; k0 += 32) a4 = __builtin_amdgcn_mfma_f32_16x16x32_bf16(*(const bf16x8*)(ap + k0), *(const bf16x8*)(bp + k0), a4, 0, 0, 0);
            LAS f32x4* px = (LAS f32x4*)lds + (wave & 3) * 64 + ln;
            if (kh == 1) *px = a4;
            LDS_WAIT(); __syncthreads();
            if (kh == 0) { a4 += *px; const float bf = args.in[I_BF][r];
#pragma unroll
                for (int j = 0; j < 4; ++j) { const float z = a4[j] + bf; const float lf = fminf(z, 0.f) - log1pf(__expf(-fabsf(z))); LOGF[(size_t)(it * 16 + q * 4 + j) * 16 + r] = lf; } }
            LDS_WAIT(); __syncthreads();
        }
        if (BOTH(1)) GRID_BAR();
    }

    if (IN(2)) {
        for (int gi = gw; gi < 32 * 128; gi += NGW) {
            const size_t off = (size_t)gi * 64 * ADH + (lane >> 4) * ADH + (lane & 15) * 8; const bf16_t* qp_ = Qb + off; const bf16_t* kp_ = Kb + off;
            float mq = 0.f, mk = 0.f, dmn = 3.0e38f;
#pragma unroll 4
            for (int i = 0; i < 16; ++i) { f32x4 a, b2, c, d; unpack8f(*(const u32x4*)(qp_ + (size_t)i * 4 * ADH), a, b2); unpack8f(*(const u32x4*)(kp_ + (size_t)i * 4 * ADH), c, d);
                float qq = ((a[0] * a[0] + a[1] * a[1]) + (a[2] * a[2] + a[3] * a[3])) + ((b2[0] * b2[0] + b2[1] * b2[1]) + (b2[2] * b2[2] + b2[3] * b2[3]));
                float kk = ((c[0] * c[0] + c[1] * c[1]) + (c[2] * c[2] + c[3] * c[3])) + ((d[0] * d[0] + d[1] * d[1]) + (d[2] * d[2] + d[3] * d[3]));
                float qk = ((a[0] * c[0] + a[1] * c[1]) + (a[2] * c[2] + a[3] * c[3])) + ((b2[0] * d[0] + b2[1] * d[1]) + (b2[2] * d[2] + b2[3] * d[3]));
#pragma unroll
                for (int o = 1; o < 16; o <<= 1) { qq += __shfl_xor(qq, o); kk += __shfl_xor(kk, o); qk += __shfl_xor(qk, o); }
                mq = fmaxf(mq, qq); mk = fmaxf(mk, kk); dmn = fminf(dmn, qk); }
#pragma unroll
            for (int o = 16; o < 64; o <<= 1) { mq = fmaxf(mq, __shfl_xor(mq, o)); mk = fmaxf(mk, __shfl_xor(mk, o)); dmn = fminf(dmn, __shfl_xor(dmn, o)); }
            if (lane == 0) { QN[gi] = sqrtf(mq) * 1.0001f; KN[gi] = sqrtf(mk) * 1.0001f; DMN[gi] = dmn - 0.0625f; }
        }
        if (cb < BATCH * AH) {
            const int b = cb >> 4, h = cb & 15; const float* src = LOGF + ((size_t)b * SEQ + tid * 16) * 16 + h;
            float v[16]; double s = 0.0;
#pragma unroll
            for (int i = 0; i < 16; ++i) v[i] = src[(size_t)i * 16];
#pragma unroll
            for (int i = 0; i < 16; ++i) s += (double)v[i];
            double incl = s;
#pragma unroll
            for (int o = 1; o < 64; o <<= 1) { const double t = __shfl_up(incl, o); if (lane >= o) incl += t; }
            LAS double* wsum = (LAS double*)lds;
            if (lane == 63) wsum[wave] = incl;
            LDS_WAIT(); __syncthreads();
            double run = incl - s;
            for (int w = 0; w < wave; ++w) run += wsum[w];
            f32x4* dst = (f32x4*)(CPR + (size_t)cb * SEQ + tid * 16);
#pragma unroll
            for (int i4 = 0; i4 < 4; ++i4) { f32x4 o;
#pragma unroll
                for (int j = 0; j < 4; ++j) { run += (double)v[4 * i4 + j]; o[j] = (float)(-run * (double)ATT_ISCALE); }
                dst[i4] = o; }
            __syncthreads();
        }
        { pg8::Gemm g{UK, 512, 512 + ZR}; pg8::S5EndOrder S{UG, WEND, cb}; pg8::EpiS5End E{UG, LB32};
          pg8::gemm_phase<pg8::EpiS5End, pg8::S5EndOrder, false>(lds, g, S, E); }
        { pg8::Gemm g{DM, DM, 512 + ZR}; pg8::KVOrder S{MN, WK, WV, cb}; pg8::EpiKV E{KS, VS};
          pg8::gemm_phase<pg8::EpiKV, pg8::KVOrder, true>(lds, g, S, E); }
        if (BOTH(2)) GRID_BAR();
    }

    if (IN(3)) {
        for (int q = cb * 512 + tid; q < 2 * 131072; q += G * 512) {
            const bool isk = q < 131072; const int e = (isk ? q : q - 131072) * 4; const float* s = (isk ? KS : VS) + e; f32x4 a = *(const f32x4*)s;
#pragma unroll
            for (int k = 1; k < 8; ++k) a += *(const f32x4*)(s + (size_t)k * 512 * 1024);
            u32x2 w; w.x = cvt_pk_bf16(a[0], a[1]); w.y = cvt_pk_bf16(a[2], a[3]); *(u32x2*)((isk ? KXB : VXTB) + e) = w;
        }
        { pg8::Gemm g{UK, UK, UK + ZR}; pg8::S5MainOrder S{UG, KT, G, cb}; pg8::EpiS5Main E{Yb};
          pg8::gemm_phase<pg8::EpiS5Main, pg8::S5MainOrder, true>(lds, g, S, E); }
        __syncthreads();
        fox::fox_phase((char*)lds_raw, MISC + 16, (unsigned*)(ctl + CW_QUEUE), (const fox::bf16*)Qb, (const fox::bf16*)Kb, (const fox::bf16*)Vb, (fox::bf16*)Ob, CPR, QN);
        if (BOTH(3)) GRID_BAR();
    }

    if (IN(4)) {
        static_assert(M % (4 * 2048) == 0, "on the 256-workgroup grid the row passes take 4 / 2 rows per wave and step");
        if (G == 256) { for (int m = gw; m < M; m += 4 * NGW) quant_rows_i8<AW, 4>(Ob, O8, SO, m, NGW, lane); }
        else { for (int m = gw; m < M; m += NGW) quant_rows_i8<AW, 1>(Ob, O8, SO, m, NGW, lane); }
        { pg8::Gemm g{SW, SW, SW + ZR}; pg8::PlainOrder S; S.init(Yb, WGLU, SW, SW, M, SW, G, cb); pg8::EpiGlu E{Yb, Y2b, args.in[I_BGLU]};
          pg8::gemm_phase<pg8::EpiGlu, pg8::PlainOrder, true>(lds, g, S, E); }
        if (BOTH(4)) GRID_BAR();
    }
    if (IN(5)) {
        { pg8::Gemm g{AW / 2, AW / 2, AW / 2 + ZR}; pg8::PlainOrder S; S.init((const bf16_t*)O8, (const bf16_t*)WAU, AW / 2, AW / 2, M, DM, G, cb);
          pg8::EpiGate<false, true> E{GATES, 0, MERGED, nullptr, SO, 1.0f / S_WAU};
          pg8::gemm_phase<pg8::EpiGate<false, true>, pg8::PlainOrder, true, 2>(lds, g, S, E); }
        VM_WAIT(); __syncthreads();
        { pg8::Gemm g{SW, SW, SW + ZR}; pg8::PlainOrder S; S.init(Y2b, WSU, SW, SW, M, DM, G, cb); pg8::EpiGate<true> E{GATES, DM, MERGED2, MERGED, nullptr, 1.0f};
          pg8::gemm_phase<pg8::EpiGate<true>, pg8::PlainOrder, true>(lds, g, S, E); }
        if (BOTH(5)) GRID_BAR();
    }
    if (IN(6)) {
        if (G == 256) { for (int m = gw; m < M; m += 2 * NGW) quant_rows_i8<DM, 2>(MERGED2, M8, SM, m, NGW, lane); }
        else { for (int m = gw; m < M; m += NGW) quant_rows_i8<DM, 1>(MERGED2, M8, SM, m, NGW, lane); }
        if (MK_N_LAUNCHES == 1) GRID_BAR();
        { pg8::Gemm g{DM / 2, DM / 2, DM / 2 + ZR}; pg8::PlainOrder S; S.init((const bf16_t*)M8, (const bf16_t*)WOUT, DM / 2, DM / 2, M, DM, G, cb); pg8::EpiRes<true, true> E{x, XB, SS1, XB, X8, 1.0f / S_W, SM};
          pg8::gemm_phase<pg8::EpiRes<true, true>, pg8::PlainOrder, true, 2>(lds, g, S, E); }
        if (BOTH(6)) GRID_BAR();
    }
    if (IN(7)) {
        { pg8::Gemm g{DM / 2, DM / 2, DM / 2 + ZR}; pg8::QxOrder S{(const bf16_t*)X8, (const bf16_t*)WQ8, DM / 2, G, cb}; const int pm0 = (cb >> 7) * 32 + (cb & 31);
          constexpr float QS8 = QSCALE_X / (S_X1 * S_W); build_rstd_table(lds, SS1, pm0, QS8);
          pg8::EpiNormed<0, true> E{SS1, QX, XW, QS8, (const LAS float*)(lds + RSTD_OFF), pm0};
          pg8::gemm_phase<pg8::EpiNormed<0, true>, pg8::QxOrder, true, 2>(lds, g, S, E); }
        if (BOTH(7)) { VM_WAIT(); __syncthreads(); }
    }
    if (IN(8)) {
        { pg8::Gemm g{XW, XW, XDH + ZR}; pg8::XsOrder S{QX, KXB, G, cb}; pg8::EpiSoftmax E{PX};
          pg8::gemm_phase<pg8::EpiSoftmax, pg8::XsOrder, false>(lds, g, S, E); }
        if (BOTH(8)) { VM_WAIT(); __syncthreads(); }
    }
    if (IN(9)) {
        { pg8::Gemm g{MEML, 512, MEML + ZR}; pg8::XoOrder S{PX, VXTB, G, cb}; pg8::EpiXo E{OX8};
          pg8::gemm_phase<pg8::EpiXo, pg8::XoOrder, true>(lds, g, S, E); }
        if (BOTH(9)) GRID_BAR();
    }
    if (IN(10)) {
        { pg8::Gemm g{XW / 2, XW / 2, XW / 2 + ZR}; pg8::PlainOrder S; S.init((const bf16_t*)OX8, (const bf16_t*)WO8, XW / 2, XW / 2, M, DM, G, cb);        pg8::EpiRes<false> E{nullptr, XB, SS2, XB, nullptr, 1.0f / 4096.0f, nullptr};
          pg8::gemm_phase<pg8::EpiRes<false>, pg8::PlainOrder, true, true>(lds, g, S, E); }
        if (BOTH(10)) GRID_BAR();
    }
    if (IN(11)) {
        { pg8::Gemm g{DM, DM, DM + ZR}; pg8::PlainOrder S; S.init(XB, FF1, DM, DM, M, DFF, G, cb); const int pm0 = 8 * (cb & 7) + ((cb >> 3) & 7); build_rstd_table(lds, SS2, pm0, 1.0f);
          pg8::EpiNormed<1> E{SS2, HID, DFF, 1.0f, (const LAS float*)(lds + RSTD_OFF), pm0};
          pg8::gemm_phase<pg8::EpiNormed<1>, pg8::PlainOrder, true>(lds, g, S, E); }
        if (BOTH(11)) GRID_BAR();
    }
    if (IN(12)) {
        { pg8::Gemm g{DFF, DFF, DFF + ZR}; pg8::DownOrder S; S.P.init(HID, FF2, DFF, DFF, M, DM, G, cb); S.A = HID; S.Bt = FF2; S.lda = DFF; S.ldb = DFF; S.c = cb; pg8::EpiRes<false> E{nullptr, XB, SS3, XB, nullptr, 1.0f, nullptr};
          pg8::gemm_phase<pg8::EpiRes<false>, pg8::DownOrder, true>(lds, g, S, E); }
        if (BOTH(12)) GRID_BAR();
    }
    if (IN(13)) {
        unsigned bad = 0u;
        if (MK_N_LAUNCHES == 1) bad = __hip_atomic_load((gu32*)(ctl + CW_BAR + XB_TMO), RLX_AGENT);
        for (int m0 = gw; m0 < M; m0 += 2 * NGW) {
            u32x4 xv[2][8]; float ssv[2];
#pragma unroll
            for (int q = 0; q < 2; ++q) { const int m = (m0 + q * NGW < M) ? m0 + q * NGW : m0; ssv[q] = SS3[(size_t)m * 64 + lane]; const GAS u32x4* xr = (const GAS u32x4*)(XB + (size_t)m * DM) + lane;
#pragma unroll
                for (int j = 0; j < 8; ++j) xv[q][j] = xr[64 * j]; }
#pragma unroll
            for (int q = 0; q < 2; ++q) { const int m = (m0 + q * NGW < M) ? m0 + q * NGW : m0;
                const float s = wave_sum(ssv[q]); float r = 1.0f / sqrtf(s * (1.0f / DM) + EPS);
                if (bad) r = __builtin_nanf("");
                GAS f32x4* orow = (GAS f32x4*)(out + (size_t)m * DM) + 2 * lane; const GAS f32x4* gr = (const GAS f32x4*)args.in[I_GFIN] + 2 * lane;
#pragma unroll
                for (int j = 0; j < 8; ++j) { f32x4 v0, v1; unpack8f(xv[q][j], v0, v1); const f32x4 g0 = gr[128 * j], g1 = gr[128 * j + 1];
                    orow[128 * j] = (f32x4){v0.x * r * g0.x, v0.y * r * g0.y, v0.z * r * g0.z, v0.w * r * g0.w}; orow[128 * j + 1] = (f32x4){v1.x * r * g1.x, v1.y * r * g1.y, v1.z * r * g1.z, v1.w * r * g1.w}; } }
        }
    }
#undef IN
#undef BOTH
#undef GRID_BAR
#undef XB
#undef WIN
#undef FF1
#undef FF2
#undef WOUT
#undef WAU
#undef WSU
#undef WGLU
#undef WQ
#undef WK
#undef WV
#undef WO
#undef MN
#undef Qb
#undef Kb
#undef Vb
#undef UG
#undef KT
#undef WEND
#undef GATES
#undef Ob
#undef Yb
#undef Y2b
#undef MERGED
#undef MERGED2
#undef QX
#undef PX
#undef OX
#undef HID
#undef KXB
#undef VXTB
#undef LOGF
#undef CPR
#undef KERN
#undef LB32
#undef SS1
#undef SS2
#undef SS3
#undef KS
#undef VS
#undef H8
#undef QN
#undef X8
#undef WQ8
#undef WO8
#undef OX8
#undef W8
#undef O8
#undef M8
#undef SO
#undef SM
#undef KN
#undef DMN
}

extern "C" void kernel_launch(void* const* d_in, const int* in_sizes, int n_in, void* d_out, int out_size, void* d_ws, size_t ws_size, hipStream_t stream) {
    static int grid = 0;
    if (grid == 0) {
        if (n_in != 29 || in_sizes[0] != M * DM || out_size != M * DM || ws_size < WS_END) { fprintf(stderr, "kernel_launch: unexpected shapes (n_in %d, in0 %d, out %d, ws %zu, need %zu)\n", n_in, n_in > 0 ? in_sizes[0] : -1, out_size, ws_size, (size_t)WS_END); grid = -1; return; }
        int dev = 0, cus = 0, per_cu = 0;
        if (hipGetDevice(&dev) != hipSuccess || hipDeviceGetAttribute(&cus, hipDeviceAttributeMultiprocessorCount, dev) != hipSuccess) { grid = -1; return; }
        if (hipFuncSetAttribute((const void*)fwd_kernel, hipFuncAttributeMaxDynamicSharedMemorySize, LDS_BYTES) != hipSuccess) { fprintf(stderr, "kernel_launch: hipFuncSetAttribute failed\n"); grid = -1; return; }
        if (hipOccupancyMaxActiveBlocksPerMultiprocessor(&per_cu, (const void*)fwd_kernel, NWAVES * 64, LDS_BYTES) != hipSuccess || per_cu < 1) { fprintf(stderr, "kernel_launch: occupancy query reports %d\n", per_cu); }
        (void)hipGetLastError();
        grid = cus;
        if (grid > 256) grid = 256;
    }
    if (grid < 0) return;
    if (hipMemsetAsync((char*)d_ws + WS_CTL, 0, CTL_ZERO_BYTES, stream) != hipSuccess) return;
    Args a{};
    for (int i = 0; i < 29; ++i) a.in[i] = (const float*)d_in[i];
    a.out = (float*)d_out; a.ws = (unsigned char*)d_ws; a.zero = 0;
    for (int li = 0; li < MK_N_LAUNCHES; ++li) {
        if (MK_N_LAUNCHES == 1) { a.ph_lo = 0; a.ph_hi = NPH; } else { a.ph_lo = li; a.ph_hi = li + 1; }
        a.li = li;
        hipLaunchKernelGGL(fwd_kernel, dim3(grid), dim3(NWAVES * 64), LDS_BYTES, stream, a);
        if (hipPeekAtLastError() != hipSuccess) { fprintf(stderr, "kernel_launch: launch %d failed\n", li); break; }
    }
}
```

```cpp
#include <hip/hip_runtime.h>
#include <hip/hip_bf16.h>
#include <cstdio>
#include <cstdint>

#ifndef MK_N_LAUNCHES
#define MK_N_LAUNCHES 1
#endif

#define GAS __attribute__((address_space(1)))
#define LAS __attribute__((address_space(3)))
typedef unsigned short bf16_t;
typedef short bf16x8 __attribute__((ext_vector_type(8)));
typedef short s16x4 __attribute__((ext_vector_type(4)));
typedef float f32x2 __attribute__((ext_vector_type(2)));
typedef float f32x4 __attribute__((ext_vector_type(4)));
typedef float f32x16 __attribute__((ext_vector_type(16)));
typedef unsigned u32x2 __attribute__((ext_vector_type(2)));
typedef unsigned u32x4 __attribute__((ext_vector_type(4)));

constexpr int BATCH = 2, SEQ = 8192, DM = 4096, M = BATCH * SEQ;
constexpr int AW = 2048, AH = 16, ADH = 128;
constexpr int SW = 1024, SG = 64, SGC = 16, SP = 64;
constexpr int INW = 15376, OFF_F = 6144, OFF_U = 6160, OFF_G = 7184;
constexpr int MEML = 256, XH = 4, XDH = 256, XW = 1024;
constexpr int DFF = 16384;
constexpr float EPS = 1e-6f;
constexpr int CT = 32, NCH = SEQ / CT, UR = BATCH * NCH, UK = CT * SGC + 2 * SP;
constexpr int WIN_ROWS = 15376;
constexpr int WIN_F = 15360;
constexpr float S_WAU = 127.0f / (4.0f * 0.02209708691207961f);
constexpr float S_H = 127.0f / 4.5f, S_W = 127.0f * 64.0f / 4.0f, S_X1 = 127.0f / 5.0f;
constexpr float QSCALE_X = 0.0625f * 1.4426950408889634f;
constexpr float ATT_ISCALE = 11.313708498984761f;

constexpr size_t MiB = 1u << 20;
constexpr size_t WS_CTL = 0, CTL_ZERO_BYTES = 1 * MiB;
constexpr size_t WS_LOGF = 1 * MiB, WS_CPR = 2 * MiB, WS_KERN = 3 * MiB, WS_LB32 = 5 * MiB, WS_KXB = 6 * MiB, WS_VXTB = 7 * MiB, WS_MN = 8 * MiB;
constexpr size_t WS_SS1 = 12 * MiB, WS_SS2 = 16 * MiB, WS_SS3 = 20 * MiB;
constexpr size_t WS_XB = 24 * MiB;
constexpr size_t WS_O = WS_XB, WS_Y = WS_XB + 64 * MiB, WS_Y2 = WS_XB + 96 * MiB;
constexpr size_t WS_FF1 = 152 * MiB, WS_FF2 = 280 * MiB;
constexpr size_t WS_WIN = 408 * MiB;
constexpr size_t WS_KS = WS_WIN, WS_VS = WS_WIN + 16 * MiB, WS_MERGED = WS_WIN;
constexpr size_t WS_WOUT = 536 * MiB, WS_WAU = 568 * MiB, WS_WSU = 584 * MiB, WS_WGLU = 592 * MiB, WS_WQ = 594 * MiB, WS_WK = 602 * MiB, WS_WV = 610 * MiB, WS_WO = 618 * MiB;
constexpr size_t WS_Q = 626 * MiB, WS_K = 690 * MiB, WS_V = 754 * MiB;
constexpr size_t WS_QX = WS_Q, WS_PX = WS_Q + 32 * MiB, WS_OX = WS_K;
constexpr size_t WS_UG = 818 * MiB, WS_KT = 858 * MiB, WS_WEND = 898 * MiB;
constexpr size_t WS_GATES = 914 * MiB;
constexpr size_t WS_HID = 408 * MiB;
constexpr size_t WS_END = 1170 * MiB;
static_assert(WS_K == WS_Q + (size_t)M * AW * 2 && WS_V == WS_K + (size_t)M * AW * 2, "q k v contiguous");
static_assert(WS_HID + (size_t)M * DFF * 2 <= WS_END && WS_GATES + (size_t)M * 8192 * 2 <= WS_END && WS_WIN + (size_t)WIN_ROWS * DM * 2 <= WS_WOUT, "ws map");
static_assert(WS_UG + (size_t)SG * UR * UK * 2 <= WS_KT && WS_KT + (size_t)SG * UR * UK * 2 <= WS_WEND && WS_WEND + (size_t)SG * 256 * 512 * 2 <= 914 * MiB, "ws map s5");

constexpr int CW_TMO = 0, CW_CODE = 1, CW_QUEUE = 64, CW_CONVQ = 128, CW_BAR = 4096;

constexpr int RING_BYTES = 131072;
constexpr int NCONV = 0, CONVCH = 8;
constexpr int LDSCTL_OFF = RING_BYTES, MISC_OFF = LDSCTL_OFF + 320;
constexpr int LDS_BYTES = 147456;
constexpr int NWAVES = 8;

#define LDS_WAIT() asm volatile("s_waitcnt lgkmcnt(0)" ::: "memory")
#define VM_WAIT() asm volatile("s_waitcnt vmcnt(0)" ::: "memory")
typedef __bf16 bf16x2_t __attribute__((ext_vector_type(2)));
__device__ __forceinline__ unsigned cvt_pk_bf16(float lo, float hi) { const f32x2 v = {lo, hi}; const bf16x2_t b = __builtin_convertvector(v, bf16x2_t); return __builtin_bit_cast(unsigned, b); }
__device__ __forceinline__ unsigned pk4_u8(float a, float b, float c, float d) {
    const unsigned x = (unsigned)fmaf(a, 255.f, 0.5f), y = (unsigned)fmaf(b, 255.f, 0.5f), z = (unsigned)fmaf(c, 255.f, 0.5f), w = (unsigned)fmaf(d, 255.f, 0.5f);
    return x | (y << 8) | (z << 16) | (w << 24);
}
__device__ __forceinline__ void unpack8u(const u32x2 g, f32x4& g0, f32x4& g1) {
    g0 = (f32x4){(float)(g.x & 0xffu), (float)((g.x >> 8) & 0xffu), (float)((g.x >> 16) & 0xffu), (float)(g.x >> 24)};
    g1 = (f32x4){(float)(g.y & 0xffu), (float)((g.y >> 8) & 0xffu), (float)((g.y >> 16) & 0xffu), (float)(g.y >> 24)};
}
__device__ __forceinline__ unsigned pk4_i8(float a, float b, float c, float d) {
    const int ia = (int)fminf(fmaxf(rintf(a), -127.f), 127.f), ib = (int)fminf(fmaxf(rintf(b), -127.f), 127.f), ic = (int)fminf(fmaxf(rintf(c), -127.f), 127.f), id = (int)fminf(fmaxf(rintf(d), -127.f), 127.f);
    return ((unsigned)ia & 255u) | (((unsigned)ib & 255u) << 8) | (((unsigned)ic & 255u) << 16) | ((unsigned)id << 24);
}
__device__ __forceinline__ unsigned pk4_fp8(float a, float b, float c, float d) { unsigned w = 0u; w = __builtin_amdgcn_cvt_pk_fp8_f32(a, b, w, false); w = __builtin_amdgcn_cvt_pk_fp8_f32(c, d, w, true); return w; }
__device__ __forceinline__ float bf_lo(unsigned w) { return __uint_as_float(w << 16); }
__device__ __forceinline__ float bf_hi(unsigned w) { return __uint_as_float(w & 0xffff0000u); }
__device__ __forceinline__ u32x4 pack8f(f32x4 a, f32x4 b) { u32x4 w; w.x = cvt_pk_bf16(a[0], a[1]); w.y = cvt_pk_bf16(a[2], a[3]); w.z = cvt_pk_bf16(b[0], b[1]); w.w = cvt_pk_bf16(b[2], b[3]); return w; }
__device__ __forceinline__ void unpack8f(u32x4 w, f32x4& a, f32x4& b) { a = (f32x4){bf_lo(w.x), bf_hi(w.x), bf_lo(w.y), bf_hi(w.y)}; b = (f32x4){bf_lo(w.z), bf_hi(w.z), bf_lo(w.w), bf_hi(w.w)}; }
__device__ __forceinline__ float sigmoidf_fast(float v) { return __builtin_amdgcn_rcpf(1.0f + __builtin_amdgcn_exp2f(-1.4426950408889634f * v)); }
__device__ __forceinline__ float wave_sum(float v) {
#pragma unroll
    for (int o = 1; o < 64; o <<= 1) v += __shfl_xor(v, o);
    return v;
}

namespace pg8 {
constexpr int BM = 256, BK = 64, HALF = 128, HTB = HALF * BK * 2, STAGE_BYTES = 8 * HTB, NXCD = 8, WGM = 8;
__host__ __device__ __forceinline__ int lds_byte(int r, int c) { const int st = (r >> 4) * 2 + (c >> 5), rr = r & 15, cc = c & 31, ob = rr * 64 + cc * 2; return st * 1024 + (ob ^ (((ob >> 9) & 1) << 5)); }
__host__ __device__ __forceinline__ void stage_rc(int b, int& R, int& C) { const int st = b / 1024, sb = b % 1024, swz = sb ^ (((sb >> 9) & 1) << 5); R = (st >> 1) * 16 + swz / 64; C = (st & 1) * 32 + (swz % 64) / 2; }
__host__ __device__ __forceinline__ int perm32(int rho) { const int n = rho >> 4, i = rho & 15; return 8 * (i >> 2) + 4 * n + (i & 3); }

struct Unit { int pm, pn, pz; const char* a; const char* b; };
struct Gemm { int lda, ldb, K; };

struct PlainOrder {
    const bf16_t* A; const bf16_t* Bt; int lda, ldb, nM, nN, nwg, G, c;
    __device__ void init(const bf16_t* A_, const bf16_t* Bt_, int lda_, int ldb_, int Mr, int Nr, int G_, int c_) { A = A_; Bt = Bt_; lda = lda_; ldb = ldb_; nM = Mr / BM; nN = Nr / BM; nwg = nM * nN; G = G_; c = c_; }
    __device__ bool next(int i, Unit& u) const {
        const long L = (long)i * G + c; if (L >= nwg) return false;
        int wgid = (int)L; { const int q = nwg / NXCD, r = nwg % NXCD, xcd = wgid % NXCD, off = wgid / NXCD; wgid = (xcd < r ? xcd * (q + 1) : r * (q + 1) + (xcd - r) * q) + off; }
        const int nig = WGM * nN, gid = wgid / nig, fm = gid * WGM, gsz = (nM - fm) < WGM ? (nM - fm) : WGM;
        u.pm = fm + ((wgid % nig) % gsz); u.pn = (wgid % nig) / gsz; u.pz = 0;
        u.a = (const char*)A + (size_t)u.pm * BM * lda * 2; u.b = (const char*)Bt + (size_t)u.pn * BM * ldb * 2; return true;
    }
};

struct DownOrder {
    PlainOrder P; const bf16_t* A; const bf16_t* Bt; int lda, ldb, c;
    __device__ bool next(int i, Unit& u) const { if (P.G != 256) return P.next(i, u); if (i >= 4) return false; const int x = c & 7, rk = c >> 3;
        u.pm = 16 * i + 4 * (x >> 1) + (rk & 3); u.pn = 8 * (x & 1) + (rk >> 2); u.pz = 0;
        u.a = (const char*)A + (size_t)u.pm * BM * lda * 2; u.b = (const char*)Bt + (size_t)u.pn * BM * ldb * 2; return true; }
};
#define PG8_ACC const f32x4 (&acc)[2][2][4][2]
typedef int i32x4 __attribute__((ext_vector_type(4)));
typedef int i32x8 __attribute__((ext_vector_type(8)));
__device__ __forceinline__ void mfma8_inplace(f32x4& c, i32x8 a, i32x8 b, int sc) { asm volatile("v_mfma_scale_f32_16x16x128_f8f6f4 %0, %1, %2, %0, %3, %3 op_sel_hi:[0,0,0]" : "+v"(c) : "v"(a), "v"(b), "v"(sc)); }
__device__ __forceinline__ i32x8 cat8(bf16x8 a, bf16x8 b) { return __builtin_shufflevector(__builtin_bit_cast(i32x4, a), __builtin_bit_cast(i32x4, b), 0, 1, 2, 3, 4, 5, 6, 7); }

template <class Epi, class Sched, bool ALIGN_EPI, int PREC = 0>
__device__ __forceinline__ void gemm_phase(LAS unsigned char* lds, const Gemm g, const Sched& S, const Epi& E) {
    int tid = threadIdx.x; asm volatile("" : "+v"(tid));
    const int wid = __builtin_amdgcn_readfirstlane(tid >> 6), lane = tid & 63, wr = wid >> 2, wc = wid & 3, fr = lane & 15, fq = lane >> 4;
    const int K = g.K, nt = K / BK;
    unsigned voffA[2], voffB[2];
#pragma unroll
    for (int i = 0; i < 2; ++i) { int R, C; stage_rc(tid * 16 + i * 8192, R, C); const int Rb = Epi::PERM ? ((R & ~31) + perm32(R & 31)) : R;
        voffA[i] = (unsigned)(R * g.lda + C) * 2u; voffB[i] = (unsigned)(Rb * g.ldb + C) * 2u; }
    const size_t kstep = (size_t)(BK * 2);
    const size_t hstepA = (size_t)HALF * g.lda * 2, hstepB = (size_t)HALF * g.ldb * 2;
    const unsigned ldsw = (unsigned)wid * 1024u;
    const int aoff = lds_byte(wr * 64 + fr, fq * 8), boff = lds_byte(wc * 32 + fr, fq * 8);
#define PG8_SA(b, h) (((b) * 2 + (h)) * HTB)
#define PG8_SB(b, h) ((4 + (b) * 2 + (h)) * HTB)
#define PG8_STAGE(bufoff, gbase, voff) do { const __amdgpu_buffer_rsrc_t rs_ = __builtin_amdgcn_make_buffer_rsrc((void*)(gbase), 0, 0x7fffffff, 0x00020000); _Pragma("unroll") for (int _i = 0; _i < 2; ++_i) \
        __builtin_amdgcn_raw_ptr_buffer_load_lds(rs_, (LAS unsigned*)(lds + (bufoff) + ldsw + _i * 8192), 16, (int)(voff)[_i], 0, 0, 0); } while (0)
#define PG8_LDA(dst, b, h) do { _Pragma("unroll") for (int m = 0; m < 4; ++m) _Pragma("unroll") for (int k = 0; k < 2; ++k) dst[m][k] = *(const LAS bf16x8*)(lds + PG8_SA(b, h) + aoff + m * 2048 + k * 1024); } while (0)
#define PG8_LDB(dst, b, h) do { _Pragma("unroll") for (int n = 0; n < 2; ++n) _Pragma("unroll") for (int k = 0; k < 2; ++k) dst[n][k] = *(const LAS bf16x8*)(lds + PG8_SB(b, h) + boff + n * 2048 + k * 1024); } while (0)
#define PG8_MMA(ai, bj, At, Bt) do { __builtin_amdgcn_s_setprio(1); _Pragma("unroll") for (int m = 0; m < 4; ++m) _Pragma("unroll") for (int n = 0; n < 2; ++n) { \
        if constexpr (PREC == 1) { mfma8_inplace(acc[ai][bj][m][n], cat8(Bt[n][0], Bt[n][1]), cat8(At[m][0], At[m][1]), sc8); } \
        else if constexpr (PREC == 2) { _Pragma("unroll") for (int k = 0; k < 2; ++k) acc[ai][bj][m][n] = __builtin_bit_cast(f32x4, __builtin_amdgcn_mfma_i32_16x16x64_i8(__builtin_bit_cast(i32x4, Bt[n][k]), __builtin_bit_cast(i32x4, At[m][k]), __builtin_bit_cast(i32x4, acc[ai][bj][m][n]), 0, 0, 0)); } \
        else { _Pragma("unroll") for (int k = 0; k < 2; ++k) acc[ai][bj][m][n] = __builtin_amdgcn_mfma_f32_16x16x32_bf16(Bt[n][k], At[m][k], acc[ai][bj][m][n], 0, 0, 0); } } \
        __builtin_amdgcn_s_setprio(0); } while (0)
#define PG8_WAIT_V(n) asm volatile("s_waitcnt vmcnt(" #n ")" ::: "memory")
#define PG8_WAIT_L(n) asm volatile("s_waitcnt lgkmcnt(" #n ")" ::: "memory")
#define PG8_BAR __builtin_amdgcn_s_barrier()
#define PG8_SCHED __builtin_amdgcn_sched_barrier(0)
    Unit cur, nxt; int ui = 0;
    if (!S.next(0, cur)) return;
    f32x4 acc[2][2][4][2];
#pragma unroll
    for (int a = 0; a < 2; ++a)
#pragma unroll
        for (int b = 0; b < 2; ++b)
#pragma unroll
            for (int m = 0; m < 4; ++m)
#pragma unroll
                for (int n = 0; n < 2; ++n) acc[a][b][m][n] = (f32x4){0.f, 0.f, 0.f, 0.f};
    bf16x8 At[4][2], B0[2][2], B1[2][2];
    int sc8 = 0x7F7F7F7F; asm volatile("" : "+v"(sc8));
    const char* cA = cur.a; const char* cB = cur.b;
    PG8_STAGE(PG8_SB(0, 0), cB, voffB); PG8_STAGE(PG8_SB(0, 1), cB + hstepB, voffB); PG8_STAGE(PG8_SA(0, 0), cA, voffA); PG8_STAGE(PG8_SA(0, 1), cA + hstepA, voffA);
    if (wr == 1) PG8_BAR;
    PG8_WAIT_V(2); PG8_BAR;
    PG8_STAGE(PG8_SB(1, 0), cB + kstep, voffB); PG8_STAGE(PG8_SA(1, 0), cA + kstep, voffA); PG8_STAGE(PG8_SB(1, 1), cB + hstepB + kstep, voffB);
    PG8_WAIT_V(6); PG8_BAR;
    for (;;) {
        const bool has_next = S.next(ui + 1, nxt);
        const char* nA = has_next ? nxt.a : cA; const char* nB = has_next ? nxt.b : cB;
        for (int t = 0; t < nt; t += 2) {
            const bool last = (t == nt - 2);
            const char* a1 = cA + (size_t)(t + 1) * kstep;
            const char* a2 = last ? nA : cA + (size_t)(t + 2) * kstep; const char* b2 = last ? nB : cB + (size_t)(t + 2) * kstep;
            const char* a3 = a2 + kstep; const char* b3 = b2 + kstep;
            PG8_LDB(B0, 0, 0); PG8_LDB(B1, 0, 1); PG8_SCHED; PG8_LDA(At, 0, 0); PG8_STAGE(PG8_SA(1, 1), a1 + hstepA, voffA);
            PG8_WAIT_V(8); PG8_WAIT_L(0); PG8_BAR; PG8_MMA(0, 0, At, B0); PG8_MMA(0, 1, At, B1); PG8_BAR; PG8_SCHED;
            PG8_LDA(At, 0, 1); PG8_STAGE(PG8_SB(0, 0), b2, voffB); PG8_STAGE(PG8_SB(0, 1), b2 + hstepB, voffB); PG8_STAGE(PG8_SA(0, 0), a2, voffA);
            PG8_WAIT_V(8); PG8_WAIT_L(0); PG8_BAR; PG8_MMA(1, 0, At, B0); PG8_MMA(1, 1, At, B1); PG8_BAR; PG8_SCHED;
            PG8_LDB(B0, 1, 0); PG8_LDB(B1, 1, 1); PG8_SCHED; PG8_LDA(At, 1, 0); PG8_STAGE(PG8_SA(0, 1), a2 + hstepA, voffA);
            PG8_WAIT_V(8); PG8_WAIT_L(0); PG8_BAR; PG8_MMA(0, 0, At, B0); PG8_MMA(0, 1, At, B1); PG8_BAR; PG8_SCHED;
            PG8_LDA(At, 1, 1); PG8_STAGE(PG8_SB(1, 0), b3, voffB); PG8_STAGE(PG8_SB(1, 1), b3 + hstepB, voffB); PG8_STAGE(PG8_SA(1, 0), a3, voffA);
            PG8_WAIT_V(8); PG8_WAIT_L(0); PG8_BAR; PG8_MMA(1, 0, At, B0); PG8_MMA(1, 1, At, B1); PG8_BAR; PG8_SCHED;
        }
        if constexpr (PREC == 1) { asm volatile("s_nop 15\n\ts_nop 15" ::: "memory"); }
        if constexpr (ALIGN_EPI) { if (wr == 0) PG8_BAR; }
        if constexpr (!Epi::AFTER_DRAIN) { E(acc, cur, wr, wc, fr, fq); }
        if (!has_next) break;
#pragma unroll
        for (int a = 0; a < 2; ++a)
#pragma unroll
            for (int b = 0; b < 2; ++b)
#pragma unroll
                for (int m = 0; m < 4; ++m)
#pragma unroll
                    for (int n = 0; n < 2; ++n) acc[a][b][m][n] = (f32x4){0.f, 0.f, 0.f, 0.f};
        cur = nxt; cA = nA; cB = nB; ++ui;
        if constexpr (ALIGN_EPI) { if (wr == 1) PG8_BAR; }
    }
    PG8_WAIT_V(0);
    if constexpr (!ALIGN_EPI) { if (wr == 0) PG8_BAR; }
    PG8_BAR;
    if constexpr (Epi::AFTER_DRAIN) { E.fused(acc, cur, wr, wc, fr, fq, lds, wid, lane); }
#undef PG8_SA
#undef PG8_SB
#undef PG8_STAGE
#undef PG8_LDA
#undef PG8_LDB
#undef PG8_MMA
#undef PG8_WAIT_V
#undef PG8_WAIT_L
#undef PG8_BAR
#undef PG8_SCHED
}

#define EPI_ROWS for (int ai = 0; ai < 2; ++ai) _Pragma("unroll") for (int m = 0; m < 4; ++m)
template <bool I8> __device__ __forceinline__ f32x4 accv(const f32x4& a) { if constexpr (I8) { const i32x4 i = __builtin_bit_cast(i32x4, a); return (f32x4){(float)i[0], (float)i[1], (float)i[2], (float)i[3]}; } else return a; }

template <bool I8> struct EpiProj {
    static constexpr bool PERM = true, AFTER_DRAIN = false;
    bf16_t* Q; bf16_t* Ug; float ascale;
    __device__ __forceinline__ void operator()(PG8_ACC, const Unit& u, int wr, int wc, int fr, int fq) const {
        const int pn = u.pn, row0 = u.pm * BM + wr * 64 + fr, cin = wc * 32 + 8 * fq;
        if (pn < 24) {
            bf16_t* base = Q + (size_t)(pn >> 3) * ((size_t)M * AW); const int hp = (pn & 7) * 2;
#pragma unroll
            EPI_ROWS { const int row = row0 + ai * HALF + m * 16, b = row >> 13, s = row & (SEQ - 1);
#pragma unroll
                for (int bj = 0; bj < 2; ++bj) { bf16_t* p = base + ((size_t)(b * AH + hp + bj) * SEQ + s) * ADH + cin; *(u32x4*)p = pack8f(accv<I8>(acc[ai][bj][m][0]) * ascale, accv<I8>(acc[ai][bj][m][1]) * ascale); } }
        } else {
#pragma unroll
            EPI_ROWS { const int row = row0 + ai * HALF + m * 16; const size_t rb = (size_t)(row >> 5) * UK + (row & 31) * SGC;
#pragma unroll
                for (int bj = 0; bj < 2; ++bj) { const int c = (pn - 24) * BM + bj * HALF + cin, gg = c >> 4, hh = c & 15;
                    bf16_t* p = Ug + (size_t)gg * UR * UK + rb + hh; *(u32x4*)p = pack8f(accv<I8>(acc[ai][bj][m][0]) * ascale, accv<I8>(acc[ai][bj][m][1]) * ascale); } }
        }
    }
};
template <bool I8> struct EpiGates8 {
    static constexpr bool PERM = true, AFTER_DRAIN = false;
    unsigned char* Gt; const float* b_gate; float ascale;
    __device__ __forceinline__ void operator()(PG8_ACC, const Unit& u, int wr, int wc, int fr, int fq) const {
        const int row0 = u.pm * BM + wr * 64 + fr, c0 = u.pn * BM + wc * 32 + 8 * fq; f32x4 bv[2][2];
#pragma unroll
        for (int bj = 0; bj < 2; ++bj)
#pragma unroll
            for (int n = 0; n < 2; ++n) bv[bj][n] = *(const f32x4*)(b_gate + c0 + bj * HALF + 4 * n);
#pragma unroll
        EPI_ROWS { const int row = row0 + ai * HALF + m * 16; unsigned char* rp = Gt + (size_t)row * 8192 + c0;
#pragma unroll
            for (int bj = 0; bj < 2; ++bj) { f32x4 v0 = accv<I8>(acc[ai][bj][m][0]) * ascale + bv[bj][0], v1 = accv<I8>(acc[ai][bj][m][1]) * ascale + bv[bj][1];
#pragma unroll
                for (int j = 0; j < 4; ++j) { v0[j] = sigmoidf_fast(v0[j]); v1[j] = sigmoidf_fast(v1[j]); }
                u32x2 w8; w8.x = pk4_u8(v0[0], v0[1], v0[2], v0[3]); w8.y = pk4_u8(v1[0], v1[1], v1[2], v1[3]); *(u32x2*)(rp + bj * HALF) = w8; } }
    }
};
struct EpiProjGates {
    static constexpr bool PERM = true, AFTER_DRAIN = false;
    EpiProj<true> p; EpiGates8<true> g;
    __device__ __forceinline__ void operator()(PG8_ACC, const Unit& u, int wr, int wc, int fr, int fq) const {
        if (u.pn < 28) p(acc, u, wr, wc, fr, fq); else { Unit v = u; v.pn = u.pn - 28; g(acc, v, wr, wc, fr, fq); }
    }
};
struct EpiKV {
    static constexpr bool PERM = false, AFTER_DRAIN = false;
    float* KS; float* VS;
    __device__ __forceinline__ void operator()(PG8_ACC, const Unit& u, int wr, int wc, int fr, int fq) const {
        const bool isk = u.pz < 64; const int ks = u.pz & 7, ldc = isk ? 1024 : 512;
        float* C = (isk ? KS : VS) + (size_t)ks * 512 * 1024;
        const int row0 = u.pm * BM + wr * 64 + fr, col0 = u.pn * BM + wc * 32 + 4 * fq;
#pragma unroll
        EPI_ROWS { float* rowp = C + (size_t)(row0 + ai * HALF + m * 16) * ldc + col0;
#pragma unroll
            for (int bj = 0; bj < 2; ++bj)
#pragma unroll
                for (int n = 0; n < 2; ++n) *(f32x4*)(rowp + bj * HALF + n * 16) = acc[ai][bj][m][n]; }
    }
};
struct EpiS5End {
    static constexpr bool PERM = false, AFTER_DRAIN = true;
    bf16_t* Ug; const float* lb32;
    __device__ __forceinline__ void fused(f32x4 (&acc)[2][2][4][2], const Unit& u, int wr, int wc, int fr, int fq, LAS unsigned char* lds, int wid, int lane) const {
        LAS float* E = (LAS float*)lds;
#pragma unroll
        EPI_ROWS { const int r = ai * HALF + wr * 64 + m * 16 + fr;
#pragma unroll
            for (int n = 0; n < 2; ++n) *(LAS f32x4*)(E + r * 128 + wc * 32 + 16 * n + 4 * fq) = acc[ai][0][m][n]; }
        asm volatile("s_waitcnt lgkmcnt(0)" ::: "memory"); __builtin_amdgcn_s_barrier(); asm volatile("" ::: "memory");
        const int g = u.pz >> 1, b = u.pz & 1;
        if (wid == 0) {
            const int p = lane; const float lr = lb32[(g * SP + p) * 2], li = lb32[(g * SP + p) * 2 + 1];
            float xr = 0.f, xi = 0.f; bf16_t* dst = Ug + ((size_t)g * UR + b * NCH) * UK + CT * SGC + p;
#pragma unroll 8
            for (int c = 0; c < NCH; ++c) { const float er = E[c * 128 + p], ei = E[c * 128 + 64 + p];
                dst[(size_t)c * UK] = (bf16_t)(cvt_pk_bf16(xr, 0.f) & 0xffffu); dst[(size_t)c * UK + SP] = (bf16_t)(cvt_pk_bf16(xi, 0.f) & 0xffffu);
                const float nr = lr * xr - li * xi + er, ni = lr * xi + li * xr + ei; xr = nr; xi = ni; }
        }
        asm volatile("s_waitcnt lgkmcnt(0)" ::: "memory"); __builtin_amdgcn_s_barrier(); asm volatile("" ::: "memory");
    }
};
struct EpiS5Main {
    static constexpr bool PERM = true, AFTER_DRAIN = false;
    bf16_t* Y;
    __device__ __forceinline__ void operator()(PG8_ACC, const Unit& u, int wr, int wc, int fr, int fq) const {
        const int g = u.pz, row0 = u.pm * BM + wr * 64 + fr, cin = u.pn * BM + wc * 32 + 8 * fq;
#pragma unroll
        EPI_ROWS { const int R = row0 + ai * HALF + m * 16;
#pragma unroll
            for (int bj = 0; bj < 2; ++bj) { const int nidx = cin + bj * HALF, t = nidx >> 4, h = nidx & 15;
                f32x4 v[2] = {acc[ai][bj][m][0], acc[ai][bj][m][1]};
#pragma unroll
                for (int n = 0; n < 2; ++n)
#pragma unroll
                    for (int j = 0; j < 4; ++j) { const float y = v[n][j]; const float z2 = 1.5957691216057308f * (y + 0.044715f * y * y * y); v[n][j] = y * sigmoidf_fast(z2); }
                *(u32x4*)(Y + ((size_t)R * CT + t) * SW + g * SGC + h) = pack8f(v[0], v[1]); } }
    }
};
struct EpiGlu {
    static constexpr bool PERM = true, AFTER_DRAIN = false;
    const bf16_t* Y; bf16_t* Y2; const float* bias;
    __device__ __forceinline__ void operator()(PG8_ACC, const Unit& u, int wr, int wc, int fr, int fq) const {
        const int row0 = u.pm * BM + wr * 64 + fr, c0 = u.pn * BM + wc * 32 + 8 * fq; f32x4 bv[2][2];
#pragma unroll
        for (int bj = 0; bj < 2; ++bj)
#pragma unroll
            for (int n = 0; n < 2; ++n) bv[bj][n] = *(const f32x4*)(bias + c0 + bj * HALF + 4 * n);
#pragma unroll
        for (int ai = 0; ai < 2; ++ai) { u32x4 yy[4][2];
#pragma unroll
            for (int m = 0; m < 4; ++m)
#pragma unroll
                for (int bj = 0; bj < 2; ++bj) yy[m][bj] = *(const u32x4*)(Y + (size_t)(row0 + ai * HALF + m * 16) * SW + c0 + bj * HALF);
#pragma unroll
            for (int m = 0; m < 4; ++m)
#pragma unroll
                for (int bj = 0; bj < 2; ++bj) { f32x4 y0, y1; unpack8f(yy[m][bj], y0, y1);
                    f32x4 v0 = acc[ai][bj][m][0] + bv[bj][0], v1 = acc[ai][bj][m][1] + bv[bj][1];
#pragma unroll
                    for (int j = 0; j < 4; ++j) { v0[j] = y0[j] * sigmoidf_fast(v0[j]); v1[j] = y1[j] * sigmoidf_fast(v1[j]); }
                    *(u32x4*)(Y2 + (size_t)(row0 + ai * HALF + m * 16) * SW + c0 + bj * HALF) = pack8f(v0, v1); } }
    }
};
template <bool ADD, bool I8 = false> struct EpiGate {
    static constexpr bool PERM = true, AFTER_DRAIN = false;
    const unsigned char* Gt; int goff; bf16_t* O; const bf16_t* Oin; const float* dq; float winv;
    __device__ __forceinline__ void operator()(PG8_ACC, const Unit& u, int wr, int wc, int fr, int fq) const {
        const int row0 = u.pm * BM + wr * 64 + fr, c0 = u.pn * BM + wc * 32 + 8 * fq;
#pragma unroll
        for (int ai = 0; ai < 2; ++ai) { u32x2 gg[4][2]; u32x4 oo[4][2]; float rsc[4];
#pragma unroll
            for (int m = 0; m < 4; ++m) { rsc[m] = (I8 ? dq[row0 + ai * HALF + m * 16] * winv : 1.0f) * (1.0f / 255.f);
#pragma unroll
                for (int bj = 0; bj < 2; ++bj) { const int row = row0 + ai * HALF + m * 16; gg[m][bj] = *(const u32x2*)(Gt + (size_t)row * 8192 + goff + c0 + bj * HALF);
                    if (ADD) oo[m][bj] = *(const u32x4*)(Oin + (size_t)row * DM + c0 + bj * HALF); } }
#pragma unroll
            for (int m = 0; m < 4; ++m)
#pragma unroll
                for (int bj = 0; bj < 2; ++bj) { const int row = row0 + ai * HALF + m * 16; f32x4 g0, g1; unpack8u(gg[m][bj], g0, g1);
                    f32x4 v0 = accv<I8>(acc[ai][bj][m][0]) * g0 * rsc[m], v1 = accv<I8>(acc[ai][bj][m][1]) * g1 * rsc[m];
                    if (ADD) { f32x4 o0, o1; unpack8f(oo[m][bj], o0, o1); v0 += o0; v1 += o1; }
                    *(u32x4*)(O + (size_t)row * DM + c0 + bj * HALF) = pack8f(v0, v1); } }
    }
};
template <bool BASE_F32, bool I8 = false> struct EpiRes {
    static constexpr bool PERM = true, AFTER_DRAIN = false;
    const float* base32; bf16_t* XB; float* ss; bf16_t* XBo; unsigned char* X8o; float ascale; const float* dq;
    __device__ __forceinline__ void operator()(PG8_ACC, const Unit& u, int wr, int wc, int fr, int fq) const {
        const int row0 = u.pm * BM + wr * 64 + fr, c0 = u.pn * BM + wc * 32 + 8 * fq;
#pragma unroll
        for (int ai = 0; ai < 2; ++ai) {
            f32x4 bf[BASE_F32 ? 4 : 1][2][2]; u32x4 bh[BASE_F32 ? 1 : 4][2];
#pragma unroll
            for (int m = 0; m < 4; ++m)
#pragma unroll
                for (int bj = 0; bj < 2; ++bj) { const size_t o = (size_t)(row0 + ai * HALF + m * 16) * DM + c0 + bj * HALF;
                    if (BASE_F32) { bf[m][bj][0] = *(const f32x4*)(base32 + o); bf[m][bj][1] = *(const f32x4*)(base32 + o + 4); } else bh[m][bj] = *(const u32x4*)(XB + o); }
#pragma unroll
            for (int m = 0; m < 4; ++m) { const int row = row0 + ai * HALF + m * 16; float q = 0.f; const float asc = I8 ? dq[row] * ascale : ascale;
#pragma unroll
                for (int bj = 0; bj < 2; ++bj) { f32x4 b0, b1; if (BASE_F32) { b0 = bf[m][bj][0]; b1 = bf[m][bj][1]; } else unpack8f(bh[m][bj], b0, b1);
                    const f32x4 v0 = b0 + accv<I8>(acc[ai][bj][m][0]) * asc, v1 = b1 + accv<I8>(acc[ai][bj][m][1]) * asc;
                    q += ((v0[0] * v0[0] + v0[1] * v0[1]) + (v0[2] * v0[2] + v0[3] * v0[3])) + ((v1[0] * v1[0] + v1[1] * v1[1]) + (v1[2] * v1[2] + v1[3] * v1[3]));
                    *(u32x4*)(XBo + (size_t)row * DM + c0 + bj * HALF) = pack8f(v0, v1);
                    if (X8o) { const f32x4 q0 = v0 * S_X1, q1 = v1 * S_X1; u32x2 w8; w8.x = pk4_i8(q0[0], q0[1], q0[2], q0[3]); w8.y = pk4_i8(q1[0], q1[1], q1[2], q1[3]); *(u32x2*)(X8o + (size_t)row * DM + c0 + bj * HALF) = w8; } }
                q += __shfl_xor(q, 16); q += __shfl_xor(q, 32);
                if (fq == 0) ss[(size_t)row * 64 + u.pn * 4 + wc] = q; } }
    }
};
__device__ __forceinline__ float row_rstd(const float* ss, int row, int fq) {
    const f32x4* p = (const f32x4*)(ss + (size_t)row * 64 + fq * 16); const f32x4 a = p[0], b = p[1], c = p[2], d = p[3];
    float s = ((a[0] + a[1]) + (a[2] + a[3])) + ((b[0] + b[1]) + (b[2] + b[3])) + ((c[0] + c[1]) + (c[2] + c[3])) + ((d[0] + d[1]) + (d[2] + d[3]));
    s += __shfl_xor(s, 16); s += __shfl_xor(s, 32);
    return 1.0f / sqrtf(s * (1.0f / DM) + EPS);
}
template <int ACT, bool I8 = false> struct EpiNormed {
    static constexpr bool PERM = true, AFTER_DRAIN = false;
    const float* ss; bf16_t* O; int ldo; float scale; const LAS float* rs; int pm0;
    __device__ __forceinline__ void operator()(PG8_ACC, const Unit& u, int wr, int wc, int fr, int fq) const {
        const int row0 = u.pm * BM + wr * 64 + fr, c0 = u.pn * BM + wc * 32 + 8 * fq; const bool fast = (u.pm == pm0);
#pragma unroll
        EPI_ROWS { const int row = row0 + ai * HALF + m * 16; const float r = fast ? rs[wr * 64 + fr + ai * HALF + m * 16] : row_rstd(ss, row, fq) * scale;
#pragma unroll
            for (int bj = 0; bj < 2; ++bj) { f32x4 v0 = accv<I8>(acc[ai][bj][m][0]) * r, v1 = accv<I8>(acc[ai][bj][m][1]) * r;
                if (ACT == 1) {
#pragma unroll
                    for (int j = 0; j < 4; ++j) { const float a = fmaxf(v0[j], 0.f), b = fmaxf(v1[j], 0.f); v0[j] = a * a; v1[j] = b * b; } }
                *(u32x4*)(O + (size_t)row * ldo + c0 + bj * HALF) = pack8f(v0, v1); } }
    }
};
struct EpiSoftmax {
    static constexpr bool PERM = true, AFTER_DRAIN = true;
    bf16_t* P;
    __device__ __forceinline__ void fused(f32x4 (&acc)[2][2][4][2], const Unit& u, int wr, int wc, int fr, int fq, LAS unsigned char* lds, int wid, int lane) const {
        LAS float* Pm = (LAS float*)lds; LAS float* Ps = (LAS float*)(lds + 4096);
#pragma unroll
        EPI_ROWS { const int r = ai * HALF + wr * 64 + m * 16 + fr; float mx = -3.0e38f;
#pragma unroll
            for (int bj = 0; bj < 2; ++bj)
#pragma unroll
                for (int n = 0; n < 2; ++n)
#pragma unroll
                    for (int j = 0; j < 4; ++j) mx = fmaxf(mx, acc[ai][bj][m][n][j]);
            mx = fmaxf(mx, __shfl_xor(mx, 16)); mx = fmaxf(mx, __shfl_xor(mx, 32));
            if (fq == 0) Pm[r * 4 + wc] = mx; }
        asm volatile("s_waitcnt lgkmcnt(0)" ::: "memory"); __builtin_amdgcn_s_barrier(); asm volatile("" ::: "memory");
#pragma unroll
        EPI_ROWS { const int r = ai * HALF + wr * 64 + m * 16 + fr; const f32x4 mm = *(const LAS f32x4*)(Pm + r * 4);
            const float mx = fmaxf(fmaxf(mm[0], mm[1]), fmaxf(mm[2], mm[3])); float s = 0.f;
#pragma unroll
            for (int bj = 0; bj < 2; ++bj)
#pragma unroll
                for (int n = 0; n < 2; ++n)
#pragma unroll
                    for (int j = 0; j < 4; ++j) { const float e = __builtin_amdgcn_exp2f(acc[ai][bj][m][n][j] - mx); acc[ai][bj][m][n][j] = e; s += e; }
            s += __shfl_xor(s, 16); s += __shfl_xor(s, 32);
            if (fq == 0) Ps[r * 4 + wc] = s; }
        asm volatile("s_waitcnt lgkmcnt(0)" ::: "memory"); __builtin_amdgcn_s_barrier(); asm volatile("" ::: "memory");
        bf16_t* Pb = P + ((size_t)u.pz * SEQ + (size_t)u.pm * BM) * MEML;
#pragma unroll
        EPI_ROWS { const int r = ai * HALF + wr * 64 + m * 16 + fr; const f32x4 sv = *(const LAS f32x4*)(Ps + r * 4);
            const float inv = 1.0f / ((sv[0] + sv[1]) + (sv[2] + sv[3]));
#pragma unroll
            for (int bj = 0; bj < 2; ++bj) *(u32x4*)(Pb + (size_t)r * MEML + bj * HALF + wc * 32 + 8 * fq) = pack8f(acc[ai][bj][m][0] * inv, acc[ai][bj][m][1] * inv); }
        asm volatile("s_waitcnt lgkmcnt(0)" ::: "memory"); __builtin_amdgcn_s_barrier(); asm volatile("" ::: "memory");
    }
};
struct EpiXo {
    static constexpr bool PERM = true, AFTER_DRAIN = false;
    unsigned char* Ox;
    __device__ __forceinline__ void operator()(PG8_ACC, const Unit& u, int wr, int wc, int fr, int fq) const {
        const int b = u.pz >> 2, h = u.pz & 3; unsigned char* Ob = Ox + ((size_t)b * SEQ + (size_t)u.pm * BM) * XW + h * XDH + wc * 32 + 8 * fq;
#pragma unroll
        EPI_ROWS { const int r = ai * HALF + wr * 64 + m * 16 + fr;
#pragma unroll
            for (int bj = 0; bj < 2; ++bj) { const f32x4 v0 = acc[ai][bj][m][0] * 16.0f, v1 = acc[ai][bj][m][1] * 16.0f; u32x2 w8; w8.x = pk4_fp8(v0[0], v0[1], v0[2], v0[3]); w8.y = pk4_fp8(v1[0], v1[1], v1[2], v1[3]);
                *(u32x2*)(Ob + (size_t)r * XW + bj * HALF) = w8; } }
    }
};

struct S5EndOrder {
    const bf16_t* Ug; const bf16_t* Wend; int c;
    __device__ bool next(int i, Unit& u) const { if (i != 0 || c >= 2 * SG) return false; const int g = c >> 1, b = c & 1; u.pm = 0; u.pn = 0; u.pz = c;
        u.a = (const char*)(Ug + ((size_t)g * UR + b * NCH) * UK); u.b = (const char*)(Wend + (size_t)g * 256 * 512); return true; }
};
struct KVOrder {
    const bf16_t* MN; const bf16_t* WK; const bf16_t* WV; int c;
    __device__ bool next(int i, Unit& u) const { if (i != 0 || c < 128 || c >= 256) return false; const int j = c - 128, tile = j >> 3, ks = j & 7;
        if (tile < 8) { u.pm = tile >> 2; u.pn = tile & 3; u.pz = ks; u.a = (const char*)(MN + (size_t)u.pm * BM * DM + ks * 512); u.b = (const char*)(WK + (size_t)u.pn * BM * DM + ks * 512); }
        else { const int tt = tile - 8; u.pm = tt >> 1; u.pn = tt & 1; u.pz = 64 + ks; u.a = (const char*)(WV + (size_t)u.pm * BM * DM + ks * 512); u.b = (const char*)(MN + (size_t)u.pn * BM * DM + ks * 512); }
        return true; }
};
struct S5MainOrder {
    const bf16_t* Ug; const bf16_t* KT; int G, c;
    __device__ bool next(int i, Unit& u) const { const int L = i * G + c; if (L >= 4 * SG) return false; const int g = L >> 2; u.pm = (L >> 1) & 1; u.pn = L & 1; u.pz = g;
        u.a = (const char*)(Ug + ((size_t)g * UR + u.pm * BM) * UK); u.b = (const char*)(KT + ((size_t)g * UR + u.pn * BM) * UK); return true; }
};
struct QxOrder {
    const bf16_t* XBp; const bf16_t* WQp; int ld, G, c;
    __device__ bool next(int i, Unit& u) const { const int L = i * G + c; if (L >= 256) return false; const int bh = L >> 5, qt = L & 31, b = bh >> 2, h = bh & 3; u.pm = b * 32 + qt; u.pn = h; u.pz = 0;
        u.a = (const char*)(XBp + (size_t)u.pm * BM * ld); u.b = (const char*)(WQp + (size_t)h * BM * ld); return true; }
};
struct XsOrder {
    const bf16_t* QX; const bf16_t* KXB; int G, c;
    __device__ bool next(int i, Unit& u) const { const int L = i * G + c; if (L >= 256) return false; const int bh = L >> 5, qt = L & 31, b = bh >> 2, h = bh & 3; u.pm = qt; u.pn = 0; u.pz = bh;
        u.a = (const char*)(QX + ((size_t)b * SEQ + (size_t)qt * BM) * XW + h * XDH); u.b = (const char*)(KXB + (size_t)b * MEML * XW + h * XDH); return true; }
};
struct XoOrder {
    const bf16_t* PX; const bf16_t* VXTB; int G, c;
    __device__ bool next(int i, Unit& u) const { const int L = i * G + c; if (L >= 256) return false; const int bh = L >> 5, qt = L & 31, b = bh >> 2, h = bh & 3; u.pm = qt; u.pn = 0; u.pz = bh;
        u.a = (const char*)(PX + ((size_t)bh * SEQ + (size_t)qt * BM) * MEML); u.b = (const char*)(VXTB + (size_t)h * XDH * 512 + b * MEML); return true; }
};
}

namespace fox {
using bf16 = __hip_bfloat16;
constexpr int D = 128, NW = 8, QBLK = 32, KVBLK = 64, QB = NW * QBLK, OP = AW;
constexpr float SCALE = 0.08838834764831845f, THR = 8.f;
constexpr int SHM_V = KVBLK * D * 2, SHM_K = KVBLK * D * 2;
constexpr int LDS_CORE = 2 * SHM_V + 2 * SHM_K + NW * 64 * 4;
constexpr int LDS_C = LDS_CORE;
constexpr int LDS_TOTAL = LDS_C + SEQ * 4;
static_assert(LDS_TOTAL <= RING_BYTES, "fox lds");
#define KSWZ(row, colB) ((row) * 256 + ((colB) ^ (((row) & 7) << 4)))
#define SBAR() __builtin_amdgcn_sched_barrier(0)
__device__ __forceinline__ int v_st(int k, int c) { const int kk = (k & ~0xC) | ((k & 4) << 1) | ((k & 8) >> 1); return ((kk >> 3) * 4 + (c >> 5)) * 512 + ((kk & 7) * 32 + (c & 31)) * 2; }
__device__ __forceinline__ int v_rd_base(int lane) { return ((lane & 3) << 3) | (((lane >> 2) & 3) << 6) | (((lane >> 4) & 1) << 5) | (((lane >> 5) & 1) << 8); }
constexpr int v_rd_off(int d0, int ks, int half) { return d0 * 512 + ks * 4096 + half * 2048; }
__device__ __forceinline__ int crow(int r, int hi) { return (r & 3) + 8 * (r >> 2) + 4 * hi; }
__device__ __forceinline__ unsigned cvtpk(float lo, float hi) { return cvt_pk_bf16(lo, hi); }
__device__ __forceinline__ bf16x8 load8(const bf16* p) { return *reinterpret_cast<const bf16x8*>(p); }
__device__ __forceinline__ void mask_tile(f32x16& p0, f32x16& p1, int dq, unsigned W) {
    const float NEG = -__builtin_inff();
#pragma unroll
    for (int r = 0; r < 16; ++r) {
        const int c = (r & 3) + 8 * (r >> 2);
        if ((unsigned)(dq - c) >= W) p0[r] = NEG;
        if ((unsigned)(dq - c - 32) >= W) p1[r] = NEG;
    }
}
__device__ __forceinline__ void partialSM(f32x16& p0, f32x16& p1, float& m_reg, float& mn, float& alpha) {
    float pmax = p0[0]; for (int r = 1; r < 16; ++r) pmax = fmaxf(pmax, p0[r]); for (int r = 0; r < 16; ++r) pmax = fmaxf(pmax, p1[r]);
    { auto rr = __builtin_amdgcn_permlane32_swap(__float_as_uint(pmax), __float_as_uint(pmax), false, false);
      pmax = fmaxf(__uint_as_float(rr[0]), __uint_as_float(rr[1])); }
    constexpr float C2 = 1.4426950408889634f * SCALE;
    if (__builtin_expect(__all((pmax - m_reg) * SCALE <= THR), 1)) { mn = m_reg; alpha = 1.f; }
    else { mn = fmaxf(m_reg, pmax); alpha = __builtin_amdgcn_exp2f((m_reg - mn) * C2); m_reg = mn; }
    const float mnL = -mn * C2;
    for (int r = 0; r < 16; ++r) p0[r] = fmaf(p0[r], C2, mnL); for (int r = 0; r < 16; ++r) p1[r] = fmaf(p1[r], C2, mnL);
    for (int r = 0; r < 16; ++r) p0[r] = __builtin_amdgcn_exp2f(p0[r]);
}
__device__ __forceinline__ void finishSM(f32x16& p0, f32x16& p1, float alpha, float& l_reg, bf16x8& pa0, bf16x8& pa1, bf16x8& pa2, bf16x8& pa3) {
    for (int r = 0; r < 16; ++r) p1[r] = __builtin_amdgcn_exp2f(p1[r]);
    float ps = 0; for (int r = 0; r < 16; ++r) ps += p0[r]; for (int r = 0; r < 16; ++r) ps += p1[r];
    { auto rr = __builtin_amdgcn_permlane32_swap(__float_as_uint(ps), __float_as_uint(ps), false, false);
      ps = __uint_as_float(rr[0]) + __uint_as_float(rr[1]); }
    l_reg = l_reg * alpha + ps;
#define PK4(P, B_, OUT) do { unsigned a0 = cvtpk(P[B_+0], P[B_+1]), a1 = cvtpk(P[B_+2], P[B_+3]);                          \
        unsigned b0 = cvtpk(P[B_+4], P[B_+5]), b1 = cvtpk(P[B_+6], P[B_+7]);                                             \
        auto r0 = __builtin_amdgcn_permlane32_swap(a0, b0, false, false); auto r1 = __builtin_amdgcn_permlane32_swap(a1, b1, false, false); \
        u32x4 w = {r0[0], r1[0], r0[1], r1[1]}; OUT = *reinterpret_cast<bf16x8*>(&w); } while (0)
    PK4(p0, 0, pa0); PK4(p0, 8, pa1); PK4(p1, 0, pa2); PK4(p1, 8, pa3);
#undef PK4
}
template <int KB>
__device__ __forceinline__ void qkt(f32x16& p0, f32x16& p1, const char* K_lds, int r32, int hi, const bf16x8* qr, const float* ck) {
#pragma unroll
    for (int a = 0; a < 4; ++a) { const f32x4 c0 = *(const f32x4*)(ck + 8 * a), c1 = *(const f32x4*)(ck + 32 + 8 * a);
#pragma unroll
        for (int j = 0; j < 4; ++j) { p0[4 * a + j] = c0[j]; p1[4 * a + j] = c1[j]; } }
    const char* kb[4];
#pragma unroll
    for (int dd = 0; dd < 4; ++dd) kb[dd] = K_lds + KB * SHM_K + KSWZ(r32, (dd * 16 + hi * 8) * 2);
#pragma unroll
    for (int d0 = 0; d0 < 8; ++d0) { const char* a = kb[d0 & 3] + (d0 >> 2) * 128;
        bf16x8 b0 = *reinterpret_cast<const bf16x8*>(a);
        bf16x8 b1 = *reinterpret_cast<const bf16x8*>(a + 32 * 256);
        p0 = __builtin_amdgcn_mfma_f32_32x32x16_bf16(b0, qr[d0], p0, 0, 0, 0);
        p1 = __builtin_amdgcn_mfma_f32_32x32x16_bf16(b1, qr[d0], p1, 0, 0, 0); }
}
template <int VB>
__device__ __forceinline__ void pv_tile(f32x16* o, int vb0, bf16x8 pa0, bf16x8 pa1, bf16x8 pa2, bf16x8 pa3) {
#define TRRD(dst, off) asm volatile("ds_read_b64_tr_b16 %0, %1 offset:%2" : "=&v"(dst) : "v"(vb0), "i"(off) : "memory")
#define PV_D0(d0) do { s16x4 l0, l1, l2, l3, h0, h1, h2, h3; constexpr int b_ = VB * SHM_V + v_rd_off(d0, 0, 0); \
        TRRD(l0, b_); TRRD(h0, b_ + 2048); TRRD(l1, b_ + 4096); TRRD(h1, b_ + 6144); TRRD(l2, b_ + 8192); TRRD(h2, b_ + 10240); TRRD(l3, b_ + 12288); TRRD(h3, b_ + 14336); \
        asm volatile("s_waitcnt lgkmcnt(0)" ::: "memory"); SBAR();   \
        o[d0] = __builtin_amdgcn_mfma_f32_32x32x16_bf16(pa0, (bf16x8){l0[0], l0[1], l0[2], l0[3], h0[0], h0[1], h0[2], h0[3]}, o[d0], 0, 0, 0);   \
        o[d0] = __builtin_amdgcn_mfma_f32_32x32x16_bf16(pa1, (bf16x8){l1[0], l1[1], l1[2], l1[3], h1[0], h1[1], h1[2], h1[3]}, o[d0], 0, 0, 0);   \
        o[d0] = __builtin_amdgcn_mfma_f32_32x32x16_bf16(pa2, (bf16x8){l2[0], l2[1], l2[2], l2[3], h2[0], h2[1], h2[2], h2[3]}, o[d0], 0, 0, 0);   \
        o[d0] = __builtin_amdgcn_mfma_f32_32x32x16_bf16(pa3, (bf16x8){l3[0], l3[1], l3[2], l3[3], h3[0], h3[1], h3[2], h3[3]}, o[d0], 0, 0, 0); } while (0)
    PV_D0(0); PV_D0(1); PV_D0(2); PV_D0(3);
#undef PV_D0
#undef TRRD
}
struct BlockRef { const bf16* Q; const bf16* K; const bf16* V; bf16* O; int P0; };
struct Seam { bf16x8 qr[8]; bf16x8 st_v0, st_v1, st_k0, st_k1; };
__device__ __forceinline__ __amdgpu_buffer_rsrc_t mk_rsrc(const void* p) { return __builtin_amdgcn_make_buffer_rsrc((void*)p, 0, SEQ * D * 2, 0x00020000); }
__device__ __forceinline__ bf16x8 bload(__amdgpu_buffer_rsrc_t r, int voff, int soff) { return __builtin_bit_cast(bf16x8, __builtin_amdgcn_raw_buffer_load_b128(r, voff, soff, 0)); }
#define VMW() asm volatile("s_waitcnt vmcnt(0)" ::: "memory")
#define VMWN(n) asm volatile("s_waitcnt vmcnt(%0)" :: "i"(n) : "memory")
#define SLOAD_H(Kp, Vp, k0) do { const __amdgpu_buffer_rsrc_t rk_ = mk_rsrc(Kp), rv_ = mk_rsrc(Vp); const int so_ = (k0) * (D * 2);                  \
                         S.st_v0 = bload(rv_, voff, so_); S.st_v1 = bload(rv_, voff, so_ + 32 * D * 2);              \
                         S.st_k0 = bload(rk_, voff, so_); S.st_k1 = bload(rk_, voff, so_ + 32 * D * 2); } while (0)
#define SWRITE_HK(bf) do { *(bf16x8*)(K_lds + (bf) * SHM_K + kws) = S.st_k0; *(bf16x8*)(K_lds + (bf) * SHM_K + kws + 32 * 256) = S.st_k1; } while (0)
#define SWRITE_HV(bf) do { *(bf16x8*)(V_lds + (bf) * SHM_V + vst0) = S.st_v0; *(bf16x8*)(V_lds + (bf) * SHM_V + vst1) = S.st_v1; } while (0)
#define SWRITE_H(bf) do { SWRITE_HV(bf); SWRITE_HK(bf); } while (0)
__device__ __forceinline__ void fox_prime(const BlockRef& cur, int j_lo, char* lds, Seam& S) {
    int tid = threadIdx.x; asm volatile("" : "+v"(tid));
    const int wid = __builtin_amdgcn_readfirstlane(tid >> 6), lane = tid & 63, r32 = lane & 31, hi = lane >> 5;
    const int sr = tid >> 4, sc = (tid & 15) * 8, kws = KSWZ(sr, sc * 2), voff = tid * 16; char* K_lds = lds + 2 * SHM_V;
    const int kb0 = j_lo * KVBLK;
    for (int d0 = 0; d0 < 8; ++d0) S.qr[d0] = load8(cur.Q + (size_t)(wid * QBLK + r32) * D + d0 * 16 + hi * 8);
    SLOAD_H(cur.K, cur.V, kb0); VMW(); SWRITE_HK(0);
    __syncthreads();
}
__device__ __forceinline__ void fox_block(const BlockRef& cur, const BlockRef& nxt, int j_lo, int jlo_n, char* lds, Seam& S) {
    int tid = threadIdx.x; asm volatile("" : "+v"(tid));
    const int wid = __builtin_amdgcn_readfirstlane(tid >> 6), lane = tid & 63, r32 = lane & 31, hi = lane >> 5;
    constexpr int W = SEQ, skv = SEQ;
    int j_hi = (cur.P0 + QB - 1) / KVBLK + 1; if (j_hi > skv / KVBLK) j_hi = skv / KVBLK;
    const int NT = j_hi - j_lo;
    const int kbn = jlo_n * KVBLK;
    const int qlo = cur.P0 + wid * QBLK, qm = qlo + r32 - 4 * hi;
    char* V_lds = lds; char* K_lds = lds + 2 * SHM_V;
    float* ws = (float*)(lds + 2 * SHM_V + 2 * SHM_K) + wid * 64; float* li_l = ws, * al_l = ws + 32;
    const float* ckb = (const float*)(lds + LDS_C) + 4 * hi;
    float m_reg = -1e30f, l_reg = 0; f32x16 o[4] = {};
    const int sr = tid >> 4, sc = (tid & 15) * 8, vst0 = v_st(sr, sc), vst1 = vst0 + 8192, kws = KSWZ(sr, sc * 2), voff = tid * 16;
    const int vb0 = (int)(uintptr_t)V_lds + v_rd_base(lane);
    const bf16* Kh = cur.K; const bf16* Vh = cur.V;
#define RESC(a) do { if (__any((a) < 1.f)) { if (hi == 0) al_l[r32] = (a); asm volatile("s_waitcnt lgkmcnt(0)" ::: "memory");              \
                     for (int d_ = 0; d_ < 4; ++d_) for (int r = 0; r < 16; ++r) o[d_][r] *= al_l[crow(r, hi)]; } } while (0)
#define KBASE(t) ((j_lo + (t)) * KVBLK)
#define MASKT(P0_, P1_, t) do { const int kb_ = KBASE(t); if (kb_ + KVBLK - 1 > qlo || kb_ <= qlo + QBLK - 1 - W) mask_tile(P0_, P1_, qm - kb_, (unsigned)W); } while (0)
    constexpr int NQL = 8;
#define SEAM_K0() do { VMWN(NQL); SWRITE_HK(0); SBAR(); } while (0)
    f32x16 pA0, pA1, pB0, pB1; float mnA, mnB, alA, alB; bf16x8 pa0, pa1, pa2, pa3;
    SWRITE_HV(0); SBAR();
    if (NT > 1) { SLOAD_H(Kh, Vh, KBASE(1)); }
    SBAR(); qkt<0>(pA0, pA1, K_lds, r32, hi, S.qr, ckb + KBASE(0));
    MASKT(pA0, pA1, 0); partialSM(pA0, pA1, m_reg, mnA, alA);
    if (NT > 1) { VMW(); SWRITE_H(1); }
    __syncthreads();
#define HALF_STEP(PX0, PX1, mnX, alX, PY0, PY1, alY, t, KB, VB, SB) do {                                                      \
        SBAR(); qkt<KB>(PX0, PX1, K_lds, r32, hi, S.qr, ckb + KBASE(t));                                                      \
        finishSM(PY0, PY1, alY, l_reg, pa0, pa1, pa2, pa3); SBAR();                                                           \
        if ((t) + 1 < NT) { SLOAD_H(Kh, Vh, KBASE((t) + 1)); SBAR(); }                                                        \
        pv_tile<VB>(o, vb0, pa0, pa1, pa2, pa3); MASKT(PX0, PX1, (t)); partialSM(PX0, PX1, m_reg, mnX, alX);                  \
        __syncthreads();                                                                                                      \
        if ((t) + 1 < NT) { VMW(); SWRITE_H(SB); }                                                                            \
        RESC(alX); __syncthreads(); } while (0)
    for (int t = 1; t + 1 < NT; t += 2) {
        HALF_STEP(pB0, pB1, mnB, alB, pA0, pA1, alA, t, 1, 0, 0);
        HALF_STEP(pA0, pA1, mnA, alA, pB0, pB1, alB, t + 1, 0, 1, 1);
    }
    const bool even = (NT & 1) == 0;
    if (even) { SBAR(); qkt<1>(pB0, pB1, K_lds, r32, hi, S.qr, ckb + KBASE(NT - 1)); SBAR(); }
    SLOAD_H(nxt.K, nxt.V, kbn); SBAR();
#pragma unroll
    for (int d0 = 0; d0 < 8; ++d0) S.qr[d0] = load8(nxt.Q + (size_t)(wid * QBLK + r32) * D + d0 * 16 + hi * 8);
    SBAR();
    finishSM(pA0, pA1, alA, l_reg, pa0, pa1, pa2, pa3); SBAR();
    pv_tile<0>(o, vb0, pa0, pa1, pa2, pa3);
    if (even) { MASKT(pB0, pB1, NT - 1); partialSM(pB0, pB1, m_reg, mnB, alB); __syncthreads(); RESC(alB);
        finishSM(pB0, pB1, alB, l_reg, pa0, pa1, pa2, pa3); SBAR(); pv_tile<1>(o, vb0, pa0, pa1, pa2, pa3); }
    SBAR(); SEAM_K0();
    if (hi == 0) li_l[r32] = l_reg; asm volatile("s_waitcnt lgkmcnt(0)" ::: "memory");
    float rli[16];
#pragma unroll
    for (int r = 0; r < 16; ++r) rli[r] = __builtin_amdgcn_rcpf(li_l[crow(r, hi)]);
    char* T = lds + LDS_C + wid * 4096;
    bf16* Ow = cur.O + (size_t)(wid * QBLK) * OP;
    int le = lane; asm volatile("" : "+v"(le));
    const int r32e = le & 31, hie = le >> 5, rrow = le >> 3, rch = le & 7, rd_off = rrow * 128 + ((rch ^ rrow) << 4);
#pragma unroll
    for (int p = 0; p < 2; ++p) {
#pragma unroll
        for (int r = 0; r < 16; ++r) { const int row = crow(r, hie), s0 = (r32e >> 3) ^ (row & 7);
            const unsigned w = cvtpk(o[2 * p][r] * rli[r], o[2 * p + 1][r] * rli[r]);
            *(unsigned short*)(T + row * 128 + (s0 << 4) + (r32e & 7) * 2) = (unsigned short)(w & 0xffffu);
            *(unsigned short*)(T + row * 128 + ((s0 ^ 4) << 4) + (r32e & 7) * 2) = (unsigned short)(w >> 16); }
        asm volatile("s_waitcnt lgkmcnt(0)" ::: "memory");
#pragma unroll
        for (int i = 0; i < 4; ++i) { const u32x4 v = *(const u32x4*)(T + i * 1024 + rd_off);
            *(u32x4*)(Ow + (size_t)(8 * i + rrow) * OP + p * 64 + rch * 8) = v; }
        asm volatile("s_waitcnt lgkmcnt(0)" ::: "memory");
    }
    __syncthreads();
#undef RESC
#undef KBASE
#undef MASKT
#undef SEAM_K0
#undef HALF_STEP
}
#undef VMW
#undef VMWN
#undef SLOAD_H
#undef SWRITE_HK
#undef SWRITE_HV
#undef SWRITE_H
constexpr float TSKIP = 20.0f * 11.313708498984761f;
__device__ __forceinline__ BlockRef fox_ref(int idx, const bf16* Q, const bf16* K, const bf16* V, bf16* O) {
    BlockRef r; const int bh = idx & 31, qb = 31 - (idx >> 5), b = bh >> 4, h = bh & 15;
    r.Q = Q + ((size_t)bh * SEQ + (size_t)qb * QB) * D; r.K = K + (size_t)bh * SEQ * D; r.V = V + (size_t)bh * SEQ * D;
    r.O = O + ((size_t)b * SEQ + (size_t)qb * QB) * OP + h * D; r.P0 = qb * QB; return r;
}
__device__ __forceinline__ int fox_jlo(const float* cpr, const float* qn, int idx) {
    int lane = threadIdx.x & 63; asm volatile("" : "+v"(lane));
    const int bh = idx & 31, qb = 31 - (idx >> 5), nfull = 4 * qb;
    const float* c = cpr + (size_t)bh * SEQ; const float* knh = qn + 65536 + bh * 128; const float* qp = qn + bh * 128 + 4 * qb;
    const float* dp = qn + 131072 + bh * 128 + 4 * qb;
    const float cq0 = c[qb * QB], Qn = fmaxf(fmaxf(qp[0], qp[1]), fmaxf(qp[2], qp[3])), dq = fminf(fminf(dp[0], dp[1]), fminf(dp[2], dp[3]));
    const float k0 = knh[lane], k1 = knh[64 + lane];
    bool keep0 = true, keep1 = true;
    if (lane < nfull) keep0 = !((cq0 - c[64 * lane + 63]) > Qn * k0 - dq + TSKIP);
    if (lane + 64 < nfull) keep1 = !((cq0 - c[64 * (lane + 64) + 63]) > Qn * k1 - dq + TSKIP);
    const unsigned long long b0 = __ballot(keep0), b1 = __ballot(keep1);
    const int jlo = b0 ? (__ffsll((long long)b0) - 1) : 64 + (__ffsll((long long)b1) - 1);
    return __builtin_amdgcn_readfirstlane(jlo);
}
__device__ __forceinline__ void fox_load_c(char* lds, const float* cpr, int idx, int j_lo) {
    const int bh = idx & 31, qb = 31 - (idx >> 5);
    const f32x4* src = (const f32x4*)(cpr + (size_t)bh * SEQ); f32x4* dst = (f32x4*)(lds + LDS_C);
    int t = threadIdx.x; asm volatile("" : "+v"(t));
    for (int i = j_lo * 16 + t; i < (qb + 1) * 64; i += 512) dst[i] = src[i];
}
__device__ __forceinline__ int fox_pop(unsigned* qctr, volatile LAS unsigned* slot) {
    if (threadIdx.x == 0) *slot = __hip_atomic_fetch_add(qctr, 1u, __ATOMIC_RELAXED, __HIP_MEMORY_SCOPE_AGENT);
    __syncthreads();
    const int v = (int)*slot;
    __syncthreads();
    return __builtin_amdgcn_readfirstlane(v);
}
__device__ __forceinline__ void fox_phase(char* lds, volatile LAS unsigned* slot, unsigned* qctr, const bf16* Q, const bf16* K, const bf16* V, bf16* O, const float* cpr, const float* qn) {
    int cur_i = fox_pop(qctr, slot); if (cur_i >= 1024) return;
    int jlo = fox_jlo(cpr, qn, cur_i);
    BlockRef cur = fox_ref(cur_i, Q, K, V, O);
    Seam S;
    fox_load_c(lds, cpr, cur_i, jlo);
    fox_prime(cur, jlo, lds, S);
    for (;;) {
        const int nxt_i = fox_pop(qctr, slot); const bool last = nxt_i >= 1024;
        const int jlo_n = last ? jlo : fox_jlo(cpr, qn, nxt_i);
        const BlockRef nxt = last ? cur : fox_ref(nxt_i, Q, K, V, O);
        fox_block(cur, nxt, jlo, jlo_n, lds, S);
        if (last) break;
        fox_load_c(lds, cpr, nxt_i, jlo_n); __syncthreads();
        cur = nxt; cur_i = nxt_i; jlo = jlo_n;
    }
}
#undef KSWZ
#undef SBAR
}

typedef GAS unsigned gu32;
#define RLX_AGENT __ATOMIC_RELAXED, __HIP_MEMORY_SCOPE_AGENT
#define XB_TMO      128
#define XB_XCNT(j)  (256  + 64 * (j))
#define XB_XSUB(j)  (1280 + 64 * (j))
#define XB_XGEN(j)  (2304 + 64 * (j))
#define XB_TOP      3328
#define XB_TOPGEN   3392
#define XCD_BAR_WORDS 3456
#define XB_SPIN_CAP (1u << 18)
__device__ __forceinline__ unsigned xb_ld(unsigned* p)              { return __hip_atomic_load(p, __ATOMIC_RELAXED, __HIP_MEMORY_SCOPE_AGENT); }
__device__ __forceinline__ unsigned xb_add(unsigned* p, unsigned v) { return __hip_atomic_fetch_add(p, v, __ATOMIC_RELAXED, __HIP_MEMORY_SCOPE_AGENT); }
__device__ __forceinline__ unsigned xb_xcc_id() { return (unsigned)__builtin_amdgcn_s_getreg((3 << 11) | 20) & 0xFu; }
#define XB_SPIN(cond, bar) do { unsigned _sp = 0; while (cond) { __builtin_amdgcn_s_sleep(1); \
    if ((++_sp & 255u) == 0u) { if (xb_ld(&(bar)[XB_TMO])) break; if (_sp > XB_SPIN_CAP) { atomicAdd(&(bar)[XB_TMO], 1u); break; } } } } while (0)
struct XcdBarrier { unsigned* bar; unsigned x; volatile LAS unsigned* st; };
__device__ __forceinline__ XcdBarrier xcd_barrier_post(unsigned* bar, volatile LAS unsigned* st) {
    XcdBarrier b; b.bar = bar; b.x = xb_xcc_id(); b.st = st;
    if (threadIdx.x == 0) (void)xb_add(&bar[XB_XCNT(b.x)], 1u);
    return b;
}
__device__ __forceinline__ void xcd_barrier_complete(unsigned* bar, unsigned x, unsigned& nloc, unsigned& nx) {
    const unsigned G = gridDim.x * gridDim.y * gridDim.z;
    unsigned sum, cnt, mine, sp = 0u;
    for (;;) {
        sum = 0u; cnt = 0u; mine = 0u;
#pragma unroll
        for (unsigned j = 0; j < 16; ++j) { const unsigned c = xb_ld(&bar[XB_XCNT(j)]); sum += c; cnt += (c > 0u) ? 1u : 0u; mine = (j == x) ? c : mine; }
        if (sum == G) break;
        __builtin_amdgcn_s_sleep(1);
        if ((++sp & 255u) == 0u) { if (xb_ld(&bar[XB_TMO])) break; if (sp > XB_SPIN_CAP) { atomicAdd(&bar[XB_TMO], 1u); break; } }
    }
    nloc = mine > 0u ? mine : 1u; nx = cnt > 0u ? cnt : 1u;
}
__device__ __forceinline__ void xcd_barrier(const XcdBarrier& b) {
    asm volatile("s_waitcnt vmcnt(0)" ::: "memory");
    __syncthreads();
    if (threadIdx.x == 0) {
        unsigned* bar = b.bar;
        __builtin_amdgcn_s_waitcnt(0);
        unsigned nloc = b.st[0], nx = b.st[1];
        if (nloc == 0u) { xcd_barrier_complete(bar, b.x, nloc, nx); b.st[0] = nloc; b.st[1] = nx; }
        const unsigned old = xb_add(&bar[XB_XSUB(b.x)], 1u);
        const unsigned gen = old / nloc;
        if (old + 1u == (gen + 1u) * nloc) {
            __builtin_amdgcn_fence(__ATOMIC_RELEASE, "agent");
            asm volatile("s_waitcnt vmcnt(0)" ::: "memory");
            const unsigned og = xb_add(&bar[XB_TOP], 1u);
            const unsigned tg = og / nx;
            if (og + 1u == (tg + 1u) * nx) xb_add(&bar[XB_TOPGEN], 1u);
            else XB_SPIN(xb_ld(&bar[XB_TOPGEN]) == tg, bar);
            __builtin_amdgcn_fence(__ATOMIC_ACQUIRE, "agent");
            xb_add(&bar[XB_XGEN(b.x)], 1u);
            asm volatile("s_waitcnt vmcnt(0)" ::: "memory");
        } else {
            XB_SPIN(xb_ld(&bar[XB_XGEN(b.x)]) == gen, bar);
            __builtin_amdgcn_fence(__ATOMIC_ACQUIRE, "agent");
            asm volatile("s_waitcnt vmcnt(0)" ::: "memory");
        }
    }
    __syncthreads();
}

__device__ __forceinline__ void p0_transpose_item(const float* W, int ldn, int col0, int nblk, int nvalid, int K, const float* gain, bf16_t* WT, int row_off, LAS float* scr, int item, int lane) {
    const int kb = item / nblk, nb = item - kb * nblk, k0 = 64 * kb, n0 = 32 * nb, rr = lane >> 3, c4 = (lane & 7) * 4;
    f32x4 v[8];
#pragma unroll
    for (int i = 0; i < 8; ++i) v[i] = (c4 < nvalid) ? *(const GAS f32x4*)(W + (size_t)(k0 + 8 * i + rr) * ldn + col0 + n0 + c4) : (f32x4){0.f, 0.f, 0.f, 0.f};
#pragma unroll
    for (int i = 0; i < 8; ++i) { const int kk = 8 * i + rr; f32x4 w = v[i]; if (gain) w = w * gain[k0 + kk];
        LAS float* d = scr + kk * 33 + c4; d[0] = w[0]; d[1] = w[1]; d[2] = w[2]; d[3] = w[3]; }
    LDS_WAIT(); asm volatile("" ::: "memory");
    const int c = lane & 7;
#pragma unroll
    for (int j = 0; j < 4; ++j) { const int n = (lane >> 3) + 8 * j; const LAS float* s = scr + (8 * c) * 33 + n;
        u32x4 o; o.x = cvt_pk_bf16(s[0 * 33], s[1 * 33]); o.y = cvt_pk_bf16(s[2 * 33], s[3 * 33]); o.z = cvt_pk_bf16(s[4 * 33], s[5 * 33]); o.w = cvt_pk_bf16(s[6 * 33], s[7 * 33]);
        if (n < nvalid) *(GAS u32x4*)(WT + (size_t)(row_off + n0 + n) * K + k0 + 8 * c) = o; }
    LDS_WAIT(); asm volatile("" ::: "memory");
}
template <bool I8> __device__ __forceinline__ void p0_transpose_item_8(const float* W, int ldn, int col0, int nblk, int K, float wscale, const float* gain, unsigned char* WT8, int row_off, LAS float* scr, int item, int lane) {
    const int kb = item / nblk, nb = item - kb * nblk, k0 = 64 * kb, n0 = 32 * nb, rr = lane >> 3, c4 = (lane & 7) * 4;
    f32x4 v[8];
#pragma unroll
    for (int i = 0; i < 8; ++i) v[i] = *(const GAS f32x4*)(W + (size_t)(k0 + 8 * i + rr) * ldn + col0 + n0 + c4);
#pragma unroll
    for (int i = 0; i < 8; ++i) { const int kk = 8 * i + rr; const f32x4 w = v[i] * (gain ? wscale * gain[k0 + kk] : wscale); LAS float* d = scr + kk * 33 + c4; d[0] = w[0]; d[1] = w[1]; d[2] = w[2]; d[3] = w[3]; }
    LDS_WAIT(); asm volatile("" ::: "memory");
    const int c = lane & 7;
#pragma unroll
    for (int j = 0; j < 4; ++j) { const int n = (lane >> 3) + 8 * j; const LAS float* s = scr + (8 * c) * 33 + n;
        u32x2 o; if constexpr (I8) { o.x = pk4_i8(s[0 * 33], s[1 * 33], s[2 * 33], s[3 * 33]); o.y = pk4_i8(s[4 * 33], s[5 * 33], s[6 * 33], s[7 * 33]); }
        else { o.x = pk4_fp8(s[0 * 33], s[1 * 33], s[2 * 33], s[3 * 33]); o.y = pk4_fp8(s[4 * 33], s[5 * 33], s[6 * 33], s[7 * 33]); }
        *(GAS u32x2*)(WT8 + (size_t)(row_off + n0 + n) * K + k0 + 8 * c) = o; }
    LDS_WAIT(); asm volatile("" ::: "memory");
}
__device__ __forceinline__ void p0_transpose_item64(const float* W, int ldn, int col0, int nblk, int K, const float* gain, bf16_t* WT, int row_off, LAS float* scr, int item, int lane) {
    const int kb = item / nblk, nb = item - kb * nblk, k0 = 64 * kb, n0 = 64 * nb, rr = lane >> 3, c4 = (lane & 7) * 4, c = lane & 7;
    f32x4 v[2][8];
#pragma unroll
    for (int i = 0; i < 8; ++i) { const GAS f32x4* sp = (const GAS f32x4*)(W + (size_t)(k0 + 8 * i + rr) * ldn + col0 + n0 + c4); v[0][i] = sp[0]; v[1][i] = sp[8]; }
#pragma unroll
    for (int h = 0; h < 2; ++h) {
#pragma unroll
        for (int i = 0; i < 8; ++i) { const int kk = 8 * i + rr; f32x4 w = v[h][i]; if (gain) w = w * gain[k0 + kk];
            LAS float* d = scr + kk * 33 + c4; d[0] = w[0]; d[1] = w[1]; d[2] = w[2]; d[3] = w[3]; }
        LDS_WAIT(); asm volatile("" ::: "memory");
#pragma unroll
        for (int j = 0; j < 4; ++j) { const int n = (lane >> 3) + 8 * j; const LAS float* s = scr + (8 * c) * 33 + n;
            u32x4 o; o.x = cvt_pk_bf16(s[0 * 33], s[1 * 33]); o.y = cvt_pk_bf16(s[2 * 33], s[3 * 33]); o.z = cvt_pk_bf16(s[4 * 33], s[5 * 33]); o.w = cvt_pk_bf16(s[6 * 33], s[7 * 33]);
            *(GAS u32x4*)(WT + (size_t)(row_off + n0 + 32 * h + n) * K + k0 + 8 * c) = o; }
        LDS_WAIT(); asm volatile("" ::: "memory");
    }
}
template <bool I8> __device__ __forceinline__ void p0_transpose_item64_8(const float* W, int ldn, int col0, int nblk, int K, float wscale, const float* gain, unsigned char* WT8, int row_off, LAS float* scr, int item, int lane) {
    const int kb = item / nblk, nb = item - kb * nblk, k0 = 64 * kb, n0 = 64 * nb, rr = lane >> 3, c4 = (lane & 7) * 4, c = lane & 7;
    f32x4 v[2][8];
#pragma unroll
    for (int i = 0; i < 8; ++i) { const GAS f32x4* sp = (const GAS f32x4*)(W + (size_t)(k0 + 8 * i + rr) * ldn + col0 + n0 + c4); v[0][i] = sp[0]; v[1][i] = sp[8]; }
#pragma unroll
    for (int h = 0; h < 2; ++h) {
#pragma unroll
        for (int i = 0; i < 8; ++i) { const int kk = 8 * i + rr; const f32x4 w = v[h][i] * (gain ? wscale * gain[k0 + kk] : wscale); LAS float* d = scr + kk * 33 + c4; d[0] = w[0]; d[1] = w[1]; d[2] = w[2]; d[3] = w[3]; }
        LDS_WAIT(); asm volatile("" ::: "memory");
#pragma unroll
        for (int j = 0; j < 4; ++j) { const int n = (lane >> 3) + 8 * j; const LAS float* s = scr + (8 * c) * 33 + n;
            u32x2 o; if constexpr (I8) { o.x = pk4_i8(s[0 * 33], s[1 * 33], s[2 * 33], s[3 * 33]); o.y = pk4_i8(s[4 * 33], s[5 * 33], s[6 * 33], s[7 * 33]); }
            else { o.x = pk4_fp8(s[0 * 33], s[1 * 33], s[2 * 33], s[3 * 33]); o.y = pk4_fp8(s[4 * 33], s[5 * 33], s[6 * 33], s[7 * 33]); }
            *(GAS u32x2*)(WT8 + (size_t)(row_off + n0 + 32 * h + n) * K + k0 + 8 * c) = o; }
        LDS_WAIT(); asm volatile("" ::: "memory");
    }
}
__device__ __forceinline__ void rms_row_to_bf16(const float* xrow, const float* gain, bf16_t* orow, unsigned char* orow8, int lane) {
    const GAS f32x4* xr = (const GAS f32x4*)xrow + lane; const GAS f32x4* gr = (const GAS f32x4*)gain + lane;
    f32x4 v[16]; float s = 0.f;
#pragma unroll
    for (int j = 0; j < 16; ++j) { v[j] = xr[64 * j]; s += (v[j].x * v[j].x + v[j].y * v[j].y) + (v[j].z * v[j].z + v[j].w * v[j].w); }
    const float r = 1.0f / sqrtf(wave_sum(s) * (1.0f / DM) + EPS);
    GAS u32x2* o8 = (GAS u32x2*)orow + lane;
#pragma unroll
    for (int j = 0; j < 16; ++j) { const f32x4 g = gr[64 * j]; const float a = v[j].x * r * g.x, b = v[j].y * r * g.y, c = v[j].z * r * g.z, d = v[j].w * r * g.w;
        u32x2 w; w.x = cvt_pk_bf16(a, b); w.y = cvt_pk_bf16(c, d); o8[64 * j] = w;
        if (orow8) ((GAS unsigned*)orow8)[lane + 64 * j] = pk4_i8(a * S_H, b * S_H, c * S_H, d * S_H); }
}
__device__ __forceinline__ void rms_rows2_to_bf16(const float* xb, const float* gain, bf16_t* ob, unsigned char* ob8, int m, int rstep, int lane) {
    const GAS f32x4* gr = (const GAS f32x4*)gain + lane;
    f32x4 v[2][16];
#pragma unroll
    for (int q = 0; q < 2; ++q) { const GAS f32x4* xr = (const GAS f32x4*)(xb + (size_t)(m + q * rstep) * DM) + lane;
#pragma unroll
        for (int j = 0; j < 16; ++j) v[q][j] = xr[64 * j]; }
#pragma unroll
    for (int q = 0; q < 2; ++q) { const size_t ro = (size_t)(m + q * rstep) * DM; float s = 0.f;
#pragma unroll
        for (int j = 0; j < 16; ++j) s += (v[q][j].x * v[q][j].x + v[q][j].y * v[q][j].y) + (v[q][j].z * v[q][j].z + v[q][j].w * v[q][j].w);
        const float r = 1.0f / sqrtf(wave_sum(s) * (1.0f / DM) + EPS);
#pragma unroll
        for (int j = 0; j < 16; ++j) { const f32x4 g = gr[64 * j]; const float a = v[q][j].x * r * g.x, b = v[q][j].y * r * g.y, c = v[q][j].z * r * g.z, d = v[q][j].w * r * g.w;
            ((GAS unsigned*)(ob8 + ro))[lane + 64 * j] = pk4_i8(a * S_H, b * S_H, c * S_H, d * S_H); } }
}
template <int NC, int R> __device__ __forceinline__ void quant_rows_i8(const bf16_t* src, unsigned char* dst, float* dq, int row0, int rstep, int lane) {
    constexpr int NJ = NC / 512; u32x4 w[R][NJ];
#pragma unroll
    for (int r = 0; r < R; ++r)
#pragma unroll
        for (int j = 0; j < NJ; ++j) w[r][j] = *(const GAS u32x4*)(src + (size_t)(row0 + r * rstep) * NC + (size_t)(j * 64 + lane) * 8);
#pragma unroll
    for (int r = 0; r < R; ++r) { const int row = row0 + r * rstep; float mx = 0.f;
#pragma unroll
        for (int j = 0; j < NJ; ++j) { f32x4 a, b; unpack8f(w[r][j], a, b);
#pragma unroll
            for (int i = 0; i < 4; ++i) mx = fmaxf(mx, fmaxf(fabsf(a[i]), fabsf(b[i]))); }
#pragma unroll
        for (int o = 1; o < 64; o <<= 1) mx = fmaxf(mx, __shfl_xor(mx, o));
        const float sc = 127.0f / fmaxf(mx, 1e-20f);
#pragma unroll
        for (int j = 0; j < NJ; ++j) { f32x4 a, b; unpack8f(w[r][j], a, b); a = a * sc; b = b * sc; u32x2 o; o.x = pk4_i8(a[0], a[1], a[2], a[3]); o.y = pk4_i8(b[0], b[1], b[2], b[3]);
            *(GAS u32x2*)(dst + (size_t)row * NC + (size_t)(j * 64 + lane) * 8) = o; }
        if (lane == 0) dq[row] = mx * (1.0f / 127.0f); }
}
__device__ __forceinline__ void s5_pow(float dt, float are, float aim, float k, float& wr, float& wi) {
    const float mag = __builtin_amdgcn_exp2f(k * dt * are * 1.4426950408889634f);
    double rev = (double)k * (double)dt * (double)aim * 0.15915494309189535; rev -= floor(rev);
    const float rf = (float)rev;
    wr = mag * __builtin_amdgcn_cosf(rf); wi = mag * __builtin_amdgcn_sinf(rf);
}
__device__ __forceinline__ void s5_f(float dt, float are, float aim, float& fre, float& fim) {
    float lr, li; s5_pow(dt, are, aim, 1.f, lr, li);
    const float den = are * are + aim * aim, nr = lr - 1.0f, ni = li;
    fre = (nr * are + ni * aim) / den; fim = (ni * are - nr * aim) / den;
}

constexpr int RSTD_OFF = RING_BYTES + 1024;
__device__ __forceinline__ void build_rstd_table(LAS unsigned char* lds, const float* ss, int pm0, float scale) {
    LAS float* rs = (LAS float*)(lds + RSTD_OFF); const int tid = threadIdx.x, r = tid >> 1, hf = tid & 1;
    const f32x4* p = (const f32x4*)(ss + ((size_t)pm0 * 256 + r) * 64 + hf * 32); float s = 0.f;
#pragma unroll
    for (int i = 0; i < 8; ++i) { const f32x4 a = p[i]; s += (a[0] + a[1]) + (a[2] + a[3]); }
    s += __shfl_xor(s, 1);
    if (hf == 0) rs[r] = scale / sqrtf(s * (1.0f / DM) + EPS);
    LDS_WAIT(); __syncthreads();
}
constexpr int NPH = 14;
struct Args { const float* in[29]; float* out; unsigned char* ws; int ph_lo, ph_hi, li, zero; };
enum { I_X = 0, I_MEM, I_GMIX, I_WIN, I_BF, I_BGATE, I_ARE, I_AIM, I_LOGDT, I_BRE, I_BIM, I_CRE, I_CIM, I_DSKIP, I_WGLU, I_BGLU, I_WAU, I_WSU, I_WOUT, I_GX, I_GMEM, I_WQ, I_WK, I_WV, I_WO, I_GMLP, I_FF1, I_FF2, I_GFIN };

__global__ void __launch_bounds__(NWAVES * 64, 2) fwd_kernel(Args args) {
    extern __shared__ __attribute__((aligned(16))) unsigned char lds_raw[];
    LAS unsigned char* lds = (LAS unsigned char*)lds_raw;
    volatile LAS unsigned* MISC = (volatile LAS unsigned*)(lds + MISC_OFF);
    const int tid = threadIdx.x, lane = tid & 63, wave = __builtin_amdgcn_readfirstlane(tid >> 6);
    const int G = gridDim.x, cb = blockIdx.x;
    const int gw = cb * NWAVES + wave, NGW = G * NWAVES;
    unsigned char* ws = args.ws;
    gu32* ctl = (gu32*)(ws + WS_CTL);
    for (int u = tid; u < (LDS_BYTES - LDSCTL_OFF) / 4; u += NWAVES * 64) ((LAS unsigned*)(lds + LDSCTL_OFF))[u] = 0u;
    __syncthreads();
    XcdBarrier bar; bar.bar = (unsigned*)(ctl + CW_BAR); bar.x = 0; bar.st = nullptr;
    if (MK_N_LAUNCHES == 1) bar = xcd_barrier_post((unsigned*)(ctl + CW_BAR), MISC + 8);
    const int lo = args.ph_lo, hi = args.ph_hi, ZR = args.zero;
#ifndef PH_MASK
#define PH_MASK 0x3fff
#endif
#define IN(k) ((((PH_MASK) >> (k)) & 1) && lo <= (k) && (k) < hi)
#define BOTH(k) (IN(k) && IN((k) + 1))
#define GRID_BAR() do { xcd_barrier(bar); } while (0)

    const float* x = args.in[I_X]; float* out = args.out;
#define XB ((bf16_t*)(ws + WS_XB))
#define WIN ((bf16_t*)(ws + WS_WIN))
#define FF1 ((bf16_t*)(ws + WS_FF1))
#define FF2 ((bf16_t*)(ws + WS_FF2))
#define WOUT ((bf16_t*)(ws + WS_WOUT))
#define WAU ((bf16_t*)(ws + WS_WAU))
#define WSU ((bf16_t*)(ws + WS_WSU))
#define WGLU ((bf16_t*)(ws + WS_WGLU))
#define WQ ((bf16_t*)(ws + WS_WQ))
#define WK ((bf16_t*)(ws + WS_WK))
#define WV ((bf16_t*)(ws + WS_WV))
#define WO ((bf16_t*)(ws + WS_WO))
#define MN ((bf16_t*)(ws + WS_MN))
#define Qb ((bf16_t*)(ws + WS_Q))
#define Kb ((bf16_t*)(ws + WS_K))
#define Vb ((bf16_t*)(ws + WS_V))
#define UG ((bf16_t*)(ws + WS_UG))
#define KT ((bf16_t*)(ws + WS_KT))
#define WEND ((bf16_t*)(ws + WS_WEND))
#define GATES ((unsigned char*)(ws + WS_GATES))
#define Ob ((bf16_t*)(ws + WS_O))
#define Yb ((bf16_t*)(ws + WS_Y))
#define Y2b ((bf16_t*)(ws + WS_Y2))
#define MERGED ((bf16_t*)(ws + WS_MERGED))
#define MERGED2 ((bf16_t*)(ws + WS_Q))
#define QX ((bf16_t*)(ws + WS_QX))
#define PX ((bf16_t*)(ws + WS_PX))
#define OX ((bf16_t*)(ws + WS_OX))
#define HID ((bf16_t*)(ws + WS_HID))
#define KXB ((bf16_t*)(ws + WS_KXB))
#define VXTB ((bf16_t*)(ws + WS_VXTB))
#define LOGF ((float*)(ws + WS_LOGF))
#define CPR ((float*)(ws + WS_CPR))
#define KERN ((float*)(ws + WS_KERN))
#define LB32 ((float*)(ws + WS_LB32))
#define SS1 ((float*)(ws + WS_SS1))
#define SS2 ((float*)(ws + WS_SS2))
#define SS3 ((float*)(ws + WS_SS3))
#define KS ((float*)(ws + WS_KS))
#define VS ((float*)(ws + WS_VS))
#define H8 ((unsigned char*)(args.out))
#define X8 ((unsigned char*)(args.out))
#define WQ8 ((unsigned char*)args.out + 96 * MiB)
#define WO8 ((unsigned char*)args.out + 100 * MiB)
#define OX8 ((unsigned char*)args.out + 104 * MiB)
#define W8 ((unsigned char*)args.out + 120 * MiB)
#define O8 ((unsigned char*)args.out + 64 * MiB)
#define M8 ((unsigned char*)args.out + 148 * MiB)
#define SO ((float*)(ws + WS_LB32 + 64 * 1024))
#define SM ((float*)(ws + WS_LB32 + 128 * 1024))
#define QN ((float*)(ws + WS_LB32 + 256 * 1024))
#define KN ((float*)(ws + WS_LB32 + 512 * 1024))
#define DMN ((float*)(ws + WS_LB32 + 768 * 1024))
    if (IN(0)) {
        LAS float* scr = (LAS float*)(lds + wave * 16384);
        {
            constexpr int I0 = (DM / 64) * (6144 / 64), I1 = (DM / 64) * (SW / 64), I2 = (DM / 64) * (8192 / 64), I3 = (DM / 64) * 1;
            constexpr int NITEMS = I0 + I1 + I2 + I3;
            for (int it = gw; it < NITEMS; it += NGW) {
                int r = it;
                if (r < I0) { p0_transpose_item64_8<true>(args.in[I_WIN], INW, 0, 6144 / 64, DM, S_W, nullptr, W8, 0, scr, r, lane); continue; } r -= I0;
                if (r < I1) { p0_transpose_item64_8<true>(args.in[I_WIN], INW, OFF_U, SW / 64, DM, S_W, nullptr, W8, 6144, scr, r, lane); continue; } r -= I1;
                if (r < I2) { p0_transpose_item64_8<true>(args.in[I_WIN], INW, OFF_G, 8192 / 64, DM, S_W, nullptr, W8, 7168, scr, r, lane); continue; } r -= I2;
                p0_transpose_item_8<true>(args.in[I_WIN], INW, OFF_F, 1, DM, S_W, nullptr, (unsigned char*)(WIN + (size_t)WIN_F * DM), 0, scr, r, lane);
            }
        }
        if (G == 256) { for (int m = gw; m < M; m += 2 * NGW) rms_rows2_to_bf16(x, args.in[I_GMIX], XB, H8, m, NGW, lane); }
        else { for (int m = gw; m < M; m += NGW) rms_row_to_bf16(x + (size_t)m * DM, args.in[I_GMIX], XB + (size_t)m * DM, H8 + (size_t)m * DM, lane); }
        for (int m = gw; m < BATCH * MEML; m += NGW) rms_row_to_bf16(args.in[I_MEM] + (size_t)m * DM, args.in[I_GMEM], MN + (size_t)m * DM, nullptr, lane);
        for (int it = gw; it < SG * CT; it += NGW) {
            const int g = it / CT, tau = it - g * CT, p = lane;
            const float dt = __builtin_amdgcn_exp2f(args.in[I_LOGDT][g] * 1.4426950408889634f), are = args.in[I_ARE][g * SP + p], aim = args.in[I_AIM][g * SP + p];
            float fre, fim, wr, wi; s5_f(dt, are, aim, fre, fim); s5_pow(dt, are, aim, (float)tau, wr, wi);
#pragma unroll
            for (int h = 0; h < SGC; ++h) { const float br = args.in[I_BRE][(g * SP + p) * SGC + h], bi = args.in[I_BIM][(g * SP + p) * SGC + h];
                const float bbr = fre * br - fim * bi, bbi = fre * bi + fim * br;
                scr[p * 17 + h] = wr * bbr - wi * bbi; scr[64 * 17 + p * 17 + h] = wr * bbi + wi * bbr; }
            LDS_WAIT(); asm volatile("" ::: "memory");
            const int h = lane >> 2, hb = (lane & 3) * 4; f32x4 acc4 = {0.f, 0.f, 0.f, 0.f};
            for (int pp = 0; pp < SP; ++pp) { const float cr = args.in[I_CRE][(g * SGC + h) * SP + pp], ci = args.in[I_CIM][(g * SGC + h) * SP + pp];
#pragma unroll
                for (int j = 0; j < 4; ++j) acc4[j] += cr * scr[pp * 17 + hb + j] - ci * scr[64 * 17 + pp * 17 + hb + j]; }
            if (tau == 0) {
#pragma unroll
                for (int j = 0; j < 4; ++j) if (hb + j == h) acc4[j] += args.in[I_DSKIP][g * SGC + h]; }
            *(f32x4*)(KERN + ((size_t)(g * CT + tau) * 256 + lane * 4)) = acc4;
            LDS_WAIT(); asm volatile("" ::: "memory");
        }
        for (int it = gw; it < SG * SP; it += NGW) {
            const int g = it >> 6, p = it & 63, s = lane >> 1, hb = (lane & 1) * 8;
            const float dt = __builtin_amdgcn_exp2f(args.in[I_LOGDT][g] * 1.4426950408889634f), are = args.in[I_ARE][g * SP + p], aim = args.in[I_AIM][g * SP + p];
            float fre, fim, wr, wi; s5_f(dt, are, aim, fre, fim); s5_pow(dt, are, aim, (float)(CT - 1 - s), wr, wi);
            const float gr = wr * fre - wi * fim, gi = wr * fim + wi * fre;
            f32x4 re[2], im[2];
#pragma unroll
            for (int j = 0; j < 8; ++j) { const float br = args.in[I_BRE][(g * SP + p) * SGC + hb + j], bi = args.in[I_BIM][(g * SP + p) * SGC + hb + j];
                re[j >> 2][j & 3] = gr * br - gi * bi; im[j >> 2][j & 3] = gr * bi + gi * br; }
            *(u32x4*)(WEND + ((size_t)g * 256 + p) * 512 + s * SGC + hb) = pack8f(re[0], re[1]);
            *(u32x4*)(WEND + ((size_t)g * 256 + 64 + p) * 512 + s * SGC + hb) = pack8f(im[0], im[1]);
        }
        for (int q = cb * 512 + tid; q < SG * 8192; q += G * 512) { const int g = q >> 13, r = q & 8191; *(u32x4*)(WEND + ((size_t)g * 256 + 128) * 512 + (size_t)r * 8) = (u32x4){0u, 0u, 0u, 0u}; }
        for (int it = gw; it < SG * CT; it += NGW) {
            const int g = it / CT, t = it - g * CT, p = lane;
            const float dt = __builtin_amdgcn_exp2f(args.in[I_LOGDT][g] * 1.4426950408889634f), are = args.in[I_ARE][g * SP + p], aim = args.in[I_AIM][g * SP + p];
            float wr, wi; s5_pow(dt, are, aim, (float)(t + 1), wr, wi);
#pragma unroll
            for (int h = 0; h < SGC; ++h) { const float cr = args.in[I_CRE][(g * SGC + h) * SP + p], ci = args.in[I_CIM][(g * SGC + h) * SP + p];
                bf16_t* rowp = KT + ((size_t)g * UR + t * SGC + h) * UK + CT * SGC;
                rowp[p] = (bf16_t)(cvt_pk_bf16(cr * wr - ci * wi, 0.f) & 0xffffu); rowp[SP + p] = (bf16_t)(cvt_pk_bf16(-(cr * wi + ci * wr), 0.f) & 0xffffu); }
        }
        for (int it = gw; it < SG; it += NGW) { const int g = it, p = lane;
            const float dt = __builtin_amdgcn_exp2f(args.in[I_LOGDT][g] * 1.4426950408889634f), are = args.in[I_ARE][g * SP + p], aim = args.in[I_AIM][g * SP + p];
            float wr, wi; s5_pow(dt, are, aim, (float)CT, wr, wi); LB32[(g * SP + p) * 2] = wr; LB32[(g * SP + p) * 2 + 1] = wi; }
        if (BOTH(0)) GRID_BAR();
    }

    if (IN(1)) {
        for (int it = gw; it < SG * CT; it += NGW) {
            const int g = it / CT, t = it - g * CT;
#pragma unroll 4
            for (int i = 0; i < 16; ++i) { const int q = i * 64 + lane, h = q >> 6, s = (q >> 1) & 31, half = q & 1;
                u32x4 w = {0u, 0u, 0u, 0u};
                if (s <= t) { const f32x4* src = (const f32x4*)(KERN + ((size_t)(g * CT + (t - s)) * SGC + h) * SGC + half * 8); w = pack8f(src[0], src[1]); }
                *(u32x4*)(KT + ((size_t)g * UR + t * SGC + h) * UK + s * SGC + half * 8) = w; }
        }
        if (cb < G - NCONV) { pg8::Gemm g{DM / 2, DM / 2, DM / 2 + ZR}; pg8::PlainOrder S; S.init((const bf16_t*)H8, (const bf16_t*)W8, DM / 2, DM / 2, M, 15360, G - NCONV, cb);
          pg8::EpiProjGates E{{Qb, UG, 1.0f / (S_H * S_W)}, {GATES, args.in[I_BGATE], 1.0f / (S_H * S_W)}};
          pg8::gemm_phase<pg8::EpiProjGates, pg8::PlainOrder, true, 2>(lds, g, S, E); }
        __syncthreads();
        {
            constexpr int I4 = (SW / 64) * (SW / 64), I5 = (AW / 64) * (DM / 64), I6 = (SW / 64) * (DM / 64), I7 = (DM / 64) * (DM / 64);
            constexpr int I8 = (DM / 64) * (XW / 64), I11 = (XW / 64) * (DM / 64), I12 = (DM / 64) * (DFF / 64), I13 = (DFF / 64) * (DM / 64);
            constexpr int NDEF = I4 + I5 + I6 + I7 + 3 * I8 + I11 + I12 + I13;
            LAS float* scr = (LAS float*)(lds + wave * 16384);
            int ln = lane; asm volatile("" : "+v"(ln));
            for (;;) {
                int base = 0; if (ln == 0) base = (int)__hip_atomic_fetch_add((unsigned*)(ctl + CW_CONVQ), (unsigned)CONVCH, __ATOMIC_RELAXED, __HIP_MEMORY_SCOPE_AGENT); base = __builtin_amdgcn_readfirstlane(base);
                if (base >= NDEF) break;
              for (int j = 0; j < CONVCH; ++j) {
                int r = base + j; if (r >= NDEF) break;
                if (r < I12) { p0_transpose_item64(args.in[I_FF1], DFF, 0, DFF / 64, DM, args.in[I_GMLP], FF1, 0, scr, r, ln); continue; } r -= I12;
                if (r < I13) { p0_transpose_item64(args.in[I_FF2], DM, 0, DM / 64, DFF, nullptr, FF2, 0, scr, r, ln); continue; } r -= I13;
                if (r < I7) { p0_transpose_item64_8<true>(args.in[I_WOUT], DM, 0, DM / 64, DM, S_W, nullptr, (unsigned char*)WOUT, 0, scr, r, ln); continue; } r -= I7;
                if (r < I5) { p0_transpose_item64_8<true>(args.in[I_WAU], DM, 0, DM / 64, AW, S_WAU, nullptr, (unsigned char*)WAU, 0, scr, r, ln); continue; } r -= I5;
                if (r < I6) { p0_transpose_item64(args.in[I_WSU], DM, 0, DM / 64, SW, nullptr, WSU, 0, scr, r, ln); continue; } r -= I6;
                if (r < I4) { p0_transpose_item64(args.in[I_WGLU], SW, 0, SW / 64, SW, nullptr, WGLU, 0, scr, r, ln); continue; } r -= I4;
                if (r < I8) { p0_transpose_item64_8<true>(args.in[I_WQ], XW, 0, XW / 64, DM, S_W, args.in[I_GX], WQ8, 0, scr, r, ln); continue; } r -= I8;
                if (r < I8) { p0_transpose_item64(args.in[I_WK], XW, 0, XW / 64, DM, nullptr, WK, 0, scr, r, ln); continue; } r -= I8;
                if (r < I8) { p0_transpose_item64(args.in[I_WV], XW, 0, XW / 64, DM, nullptr, WV, 0, scr, r, ln); continue; } r -= I8;
                p0_transpose_item64_8<false>(args.in[I_WO], DM, 0, DM / 64, XW, 256.0f, nullptr, WO8, 0, scr, r, ln);
              }
            }
        }
        __syncthreads();
        int ln = lane; asm volatile("" : "+v"(ln));
        for (int it0 = cb * 4; it0 < M / 16; it0 += G * 4) {
            const int it = it0 + (wave & 3), kh = wave >> 2, r = ln & 15, q = ln >> 4;
            const unsigned char* ap = H8 + (size_t)(it * 16 + r) * DM + kh * (DM / 2) + q * 16; const unsigned char* bp = (const unsigned char*)(WIN + (size_t)WIN_F * DM) + (size_t)r * DM + kh * (DM / 2) + q * 16;
            pg8::i32x4 s4 = {0, 0, 0, 0};
#pragma unroll 16
            for (int k0 = 0; k0 < DM / 2; k0 += 64) s4 = __builtin_amdgcn_mfma_i32_16x16x64_i8(*(const pg8::i32x4*)(ap + k0), *(const pg8::i32x4*)(bp + k0), s4, 0, 0, 0);
            f32x4 a4 = {(float)s4[0], (float)s4[1], (float)s4[2], (float)s4[3]}; a4 = a4 * (1.0f / (S_H * S_W));
            LAS f32x4* px = (LAS f32x4*)lds + (wave & 3) * 64 + ln;
            if (kh == 1) *px = a4;
            LDS_WAIT(); __syncthreads();
            if (kh == 0) { a4 += *px; const float bf = args.in[I_BF][r];
#pragma unroll
                for (int j = 0; j < 4; ++j) { const float z = a4[j] + bf; const float lf = fminf(z, 0.f) - log1pf(__expf(-fabsf(z))); LOGF[(size_t)(it * 16 + q * 4 + j) * 16 + r] = lf; } }
            LDS_WAIT(); __syncthreads();
        }
        if (BOTH(1)) GRID_BAR();
    }

    if (IN(2)) {
        for (int gi = gw; gi < 32 * 128; gi += NGW) {
            const size_t off = (size_t)gi * 64 * ADH + (lane >> 4) * ADH + (lane & 15) * 8; const bf16_t* qp_ = Qb + off; const bf16_t* kp_ = Kb + off;
            float mq = 0.f, mk = 0.f, dmn = 3.0e38f;
#pragma unroll 4
            for (int i = 0; i < 16; ++i) { f32x4 a, b2, c, d; unpack8f(*(const u32x4*)(qp_ + (size_t)i * 4 * ADH), a, b2); unpack8f(*(const u32x4*)(kp_ + (size_t)i * 4 * ADH), c, d);
                float qq = ((a[0] * a[0] + a[1] * a[1]) + (a[2] * a[2] + a[3] * a[3])) + ((b2[0] * b2[0] + b2[1] * b2[1]) + (b2[2] * b2[2] + b2[3] * b2[3]));
                float kk = ((c[0] * c[0] + c[1] * c[1]) + (c[2] * c[2] + c[3] * c[3])) + ((d[0] * d[0] + d[1] * d[1]) + (d[2] * d[2] + d[3] * d[3]));
                float qk = ((a[0] * c[0] + a[1] * c[1]) + (a[2] * c[2] + a[3] * c[3])) + ((b2[0] * d[0] + b2[1] * d[1]) + (b2[2] * d[2] + b2[3] * d[3]));
#pragma unroll
                for (int o = 1; o < 16; o <<= 1) { qq += __shfl_xor(qq, o); kk += __shfl_xor(kk, o); qk += __shfl_xor(qk, o); }
                mq = fmaxf(mq, qq); mk = fmaxf(mk, kk); dmn = fminf(dmn, qk); }
#pragma unroll
            for (int o = 16; o < 64; o <<= 1) { mq = fmaxf(mq, __shfl_xor(mq, o)); mk = fmaxf(mk, __shfl_xor(mk, o)); dmn = fminf(dmn, __shfl_xor(dmn, o)); }
            if (lane == 0) { QN[gi] = sqrtf(mq) * 1.0001f; KN[gi] = sqrtf(mk) * 1.0001f; DMN[gi] = dmn - 0.0625f; }
        }
        if (cb < BATCH * AH) {
            const int b = cb >> 4, h = cb & 15; const float* src = LOGF + ((size_t)b * SEQ + tid * 16) * 16 + h;
            float v[16]; double s = 0.0;
#pragma unroll
            for (int i = 0; i < 16; ++i) v[i] = src[(size_t)i * 16];
#pragma unroll
            for (int i = 0; i < 16; ++i) s += (double)v[i];
            double incl = s;
#pragma unroll
            for (int o = 1; o < 64; o <<= 1) { const double t = __shfl_up(incl, o); if (lane >= o) incl += t; }
            LAS double* wsum = (LAS double*)lds;
            if (lane == 63) wsum[wave] = incl;
            LDS_WAIT(); __syncthreads();
            double run = incl - s;
            for (int w = 0; w < wave; ++w) run += wsum[w];
            f32x4* dst = (f32x4*)(CPR + (size_t)cb * SEQ + tid * 16);
#pragma unroll
            for (int i4 = 0; i4 < 4; ++i4) { f32x4 o;
#pragma unroll
                for (int j = 0; j < 4; ++j) { run += (double)v[4 * i4 + j]; o[j] = (float)(-run * (double)ATT_ISCALE); }
                dst[i4] = o; }
            __syncthreads();
        }
        { pg8::Gemm g{UK, 512, 512 + ZR}; pg8::S5EndOrder S{UG, WEND, cb}; pg8::EpiS5End E{UG, LB32};
          pg8::gemm_phase<pg8::EpiS5End, pg8::S5EndOrder, false>(lds, g, S, E); }
        { pg8::Gemm g{DM, DM, 512 + ZR}; pg8::KVOrder S{MN, WK, WV, cb}; pg8::EpiKV E{KS, VS};
          pg8::gemm_phase<pg8::EpiKV, pg8::KVOrder, true>(lds, g, S, E); }
        if (BOTH(2)) GRID_BAR();
    }

    if (IN(3)) {
        for (int q = cb * 512 + tid; q < 2 * 131072; q += G * 512) {
            const bool isk = q < 131072; const int e = (isk ? q : q - 131072) * 4; const float* s = (isk ? KS : VS) + e; f32x4 a = *(const f32x4*)s;
#pragma unroll
            for (int k = 1; k < 8; ++k) a += *(const f32x4*)(s + (size_t)k * 512 * 1024);
            u32x2 w; w.x = cvt_pk_bf16(a[0], a[1]); w.y = cvt_pk_bf16(a[2], a[3]); *(u32x2*)((isk ? KXB : VXTB) + e) = w;
        }
        { pg8::Gemm g{UK, UK, UK + ZR}; pg8::S5MainOrder S{UG, KT, G, cb}; pg8::EpiS5Main E{Yb};
          pg8::gemm_phase<pg8::EpiS5Main, pg8::S5MainOrder, true>(lds, g, S, E); }
        __syncthreads();
        fox::fox_phase((char*)lds_raw, MISC + 16, (unsigned*)(ctl + CW_QUEUE), (const fox::bf16*)Qb, (const fox::bf16*)Kb, (const fox::bf16*)Vb, (fox::bf16*)Ob, CPR, QN);
        if (BOTH(3)) GRID_BAR();
    }

    if (IN(4)) {
        static_assert(M % (4 * 2048) == 0, "on the 256-workgroup grid the row passes take 4 / 2 rows per wave and step");
        if (G == 256) { for (int m = gw; m < M; m += 4 * NGW) quant_rows_i8<AW, 4>(Ob, O8, SO, m, NGW, lane); }
        else { for (int m = gw; m < M; m += NGW) quant_rows_i8<AW, 1>(Ob, O8, SO, m, NGW, lane); }
        { pg8::Gemm g{SW, SW, SW + ZR}; pg8::PlainOrder S; S.init(Yb, WGLU, SW, SW, M, SW, G, cb); pg8::EpiGlu E{Yb, Y2b, args.in[I_BGLU]};
          pg8::gemm_phase<pg8::EpiGlu, pg8::PlainOrder, true>(lds, g, S, E); }
        if (BOTH(4)) GRID_BAR();
    }
    if (IN(5)) {
        { pg8::Gemm g{AW / 2, AW / 2, AW / 2 + ZR}; pg8::PlainOrder S; S.init((const bf16_t*)O8, (const bf16_t*)WAU, AW / 2, AW / 2, M, DM, G, cb);
          pg8::EpiGate<false, true> E{GATES, 0, MERGED, nullptr, SO, 1.0f / S_WAU};
          pg8::gemm_phase<pg8::EpiGate<false, true>, pg8::PlainOrder, true, 2>(lds, g, S, E); }
        VM_WAIT(); __syncthreads();
        { pg8::Gemm g{SW, SW, SW + ZR}; pg8::PlainOrder S; S.init(Y2b, WSU, SW, SW, M, DM, G, cb); pg8::EpiGate<true> E{GATES, DM, MERGED2, MERGED, nullptr, 1.0f};
          pg8::gemm_phase<pg8::EpiGate<true>, pg8::PlainOrder, true>(lds, g, S, E); }
        if (BOTH(5)) GRID_BAR();
    }
    if (IN(6)) {
        if (G == 256) { for (int m = gw; m < M; m += 2 * NGW) quant_rows_i8<DM, 2>(MERGED2, M8, SM, m, NGW, lane); }
        else { for (int m = gw; m < M; m += NGW) quant_rows_i8<DM, 1>(MERGED2, M8, SM, m, NGW, lane); }
        if (MK_N_LAUNCHES == 1) GRID_BAR();
        { pg8::Gemm g{DM / 2, DM / 2, DM / 2 + ZR}; pg8::PlainOrder S; S.init((const bf16_t*)M8, (const bf16_t*)WOUT, DM / 2, DM / 2, M, DM, G, cb); pg8::EpiRes<true, true> E{x, XB, SS1, XB, X8, 1.0f / S_W, SM};
          pg8::gemm_phase<pg8::EpiRes<true, true>, pg8::PlainOrder, true, 2>(lds, g, S, E); }
        if (BOTH(6)) GRID_BAR();
    }
    if (IN(7)) {
        { pg8::Gemm g{DM / 2, DM / 2, DM / 2 + ZR}; pg8::QxOrder S{(const bf16_t*)X8, (const bf16_t*)WQ8, DM / 2, G, cb}; const int pm0 = (cb >> 7) * 32 + (cb & 31);
          constexpr float QS8 = QSCALE_X / (S_X1 * S_W); build_rstd_table(lds, SS1, pm0, QS8);
          pg8::EpiNormed<0, true> E{SS1, QX, XW, QS8, (const LAS float*)(lds + RSTD_OFF), pm0};
          pg8::gemm_phase<pg8::EpiNormed<0, true>, pg8::QxOrder, true, 2>(lds, g, S, E); }
        if (BOTH(7)) { VM_WAIT(); __syncthreads(); }
    }
    if (IN(8)) {
        { pg8::Gemm g{XW, XW, XDH + ZR}; pg8::XsOrder S{QX, KXB, G, cb}; pg8::EpiSoftmax E{PX};
          pg8::gemm_phase<pg8::EpiSoftmax, pg8::XsOrder, false>(lds, g, S, E); }
        if (BOTH(8)) { VM_WAIT(); __syncthreads(); }
    }
    if (IN(9)) {
        { pg8::Gemm g{MEML, 512, MEML + ZR}; pg8::XoOrder S{PX, VXTB, G, cb}; pg8::EpiXo E{OX8};
          pg8::gemm_phase<pg8::EpiXo, pg8::XoOrder, true>(lds, g, S, E); }
        if (BOTH(9)) GRID_BAR();
    }
    if (IN(10)) {
        { pg8::Gemm g{XW / 2, XW / 2, XW / 2 + ZR}; pg8::PlainOrder S; S.init((const bf16_t*)OX8, (const bf16_t*)WO8, XW / 2, XW / 2, M, DM, G, cb);        pg8::EpiRes<false> E{nullptr, XB, SS2, XB, nullptr, 1.0f / 4096.0f, nullptr};
          pg8::gemm_phase<pg8::EpiRes<false>, pg8::PlainOrder, true, true>(lds, g, S, E); }
        if (BOTH(10)) GRID_BAR();
    }
    if (IN(11)) {
        { pg8::Gemm g{DM, DM, DM + ZR}; pg8::PlainOrder S; S.init(XB, FF1, DM, DM, M, DFF, G, cb); const int pm0 = 8 * (cb & 7) + ((cb >> 3) & 7); build_rstd_table(lds, SS2, pm0, 1.0f);
          pg8::EpiNormed<1> E{SS2, HID, DFF, 1.0f, (const LAS float*)(lds + RSTD_OFF), pm0};
          pg8::gemm_phase<pg8::EpiNormed<1>, pg8::PlainOrder, true>(lds, g, S, E); }
        if (BOTH(11)) GRID_BAR();
    }
    if (IN(12)) {
        { pg8::Gemm g{DFF, DFF, DFF + ZR}; pg8::DownOrder S; S.P.init(HID, FF2, DFF, DFF, M, DM, G, cb); S.A = HID; S.Bt = FF2; S.lda = DFF; S.ldb = DFF; S.c = cb; pg8::EpiRes<false> E{nullptr, XB, SS3, XB, nullptr, 1.0f, nullptr};
          pg8::gemm_phase<pg8::EpiRes<false>, pg8::DownOrder, true>(lds, g, S, E); }
        if (BOTH(12)) GRID_BAR();
    }
    if (IN(13)) {
        unsigned bad = 0u;
        if (MK_N_LAUNCHES == 1) bad = __hip_atomic_load((gu32*)(ctl + CW_BAR + XB_TMO), RLX_AGENT);
        for (int m0 = gw; m0 < M; m0 += 2 * NGW) {
            u32x4 xv[2][8]; float ssv[2];
#pragma unroll
            for (int q = 0; q < 2; ++q) { const int m = (m0 + q * NGW < M) ? m0 + q * NGW : m0; ssv[q] = SS3[(size_t)m * 64 + lane]; const GAS u32x4* xr = (const GAS u32x4*)(XB + (size_t)m * DM) + lane;
#pragma unroll
                for (int j = 0; j < 8; ++j) xv[q][j] = xr[64 * j]; }
#pragma unroll
            for (int q = 0; q < 2; ++q) { const int m = (m0 + q * NGW < M) ? m0 + q * NGW : m0;
                const float s = wave_sum(ssv[q]); float r = 1.0f / sqrtf(s * (1.0f / DM) + EPS);
                if (bad) r = __builtin_nanf("");
                GAS f32x4* orow = (GAS f32x4*)(out + (size_t)m * DM) + 2 * lane; const GAS f32x4* gr = (const GAS f32x4*)args.in[I_GFIN] + 2 * lane;
#pragma unroll
                for (int j = 0; j < 8; ++j) { f32x4 v0, v1; unpack8f(xv[q][j], v0, v1); const f32x4 g0 = gr[128 * j], g1 = gr[128 * j + 1];
                    orow[128 * j] = (f32x4){v0.x * r * g0.x, v0.y * r * g0.y, v0.z * r * g0.z, v0.w * r * g0.w}; orow[128 * j + 1] = (f32x4){v1.x * r * g1.x, v1.y * r * g1.y, v1.z * r * g1.z, v1.w * r * g1.w}; } }
        }
    }
#undef IN
#undef BOTH
#undef GRID_BAR
#undef XB
#undef WIN
#undef FF1
#undef FF2
#undef WOUT
#undef WAU
#undef WSU
#undef WGLU
#undef WQ
#undef WK
#undef WV
#undef WO
#undef MN
#undef Qb
#undef Kb
#undef Vb
#undef UG
#undef KT
#undef WEND
#undef GATES
#undef Ob
#undef Yb
#undef Y2b
#undef MERGED
#undef MERGED2
#undef QX
#undef PX
#undef OX
#undef HID
#undef KXB
#undef VXTB
#undef LOGF
#undef CPR
#undef KERN
#undef LB32
#undef SS1
#undef SS2
#undef SS3
#undef KS
#undef VS
#undef H8
#undef QN
#undef X8
#undef WQ8
#undef WO8
#undef OX8
#undef W8
#undef O8
#undef M8
#undef SO
#undef SM
#undef KN
#undef DMN
}

extern "C" void kernel_launch(void* const* d_in, const int* in_sizes, int n_in, void* d_out, int out_size, void* d_ws, size_t ws_size, hipStream_t stream) {
    static int grid = 0;
    if (grid == 0) {
        if (n_in != 29 || in_sizes[0] != M * DM || out_size != M * DM || ws_size < WS_END) { fprintf(stderr, "kernel_launch: unexpected shapes (n_in %d, in0 %d, out %d, ws %zu, need %zu)\n", n_in, n_in > 0 ? in_sizes[0] : -1, out_size, ws_size, (size_t)WS_END); grid = -1; return; }
        int dev = 0, cus = 0, per_cu = 0;
        if (hipGetDevice(&dev) != hipSuccess || hipDeviceGetAttribute(&cus, hipDeviceAttributeMultiprocessorCount, dev) != hipSuccess) { grid = -1; return; }
        if (hipFuncSetAttribute((const void*)fwd_kernel, hipFuncAttributeMaxDynamicSharedMemorySize, LDS_BYTES) != hipSuccess) { fprintf(stderr, "kernel_launch: hipFuncSetAttribute failed\n"); grid = -1; return; }
        if (hipOccupancyMaxActiveBlocksPerMultiprocessor(&per_cu, (const void*)fwd_kernel, NWAVES * 64, LDS_BYTES) != hipSuccess || per_cu < 1) { fprintf(stderr, "kernel_launch: occupancy query reports %d\n", per_cu); }
        (void)hipGetLastError();
        grid = cus;
        if (grid > 256) grid = 256;
    }
    if (grid < 0) return;
    if (hipMemsetAsync((char*)d_ws + WS_CTL, 0, CTL_ZERO_BYTES, stream) != hipSuccess) return;
    Args a{};
    for (int i = 0; i < 29; ++i) a.in[i] = (const float*)d_in[i];
    a.out = (float*)d_out; a.ws = (unsigned char*)d_ws; a.zero = 0;
    for (int li = 0; li < MK_N_LAUNCHES; ++li) {
        if (MK_N_LAUNCHES == 1) { a.ph_lo = 0; a.ph_hi = NPH; } else { a.ph_lo = li; a.ph_hi = li + 1; }
        a.li = li;
        hipLaunchKernelGGL(fwd_kernel, dim3(grid), dim3(NWAVES * 64), LDS_BYTES, stream, a);
        if (hipPeekAtLastError() != hipSuccess) { fprintf(stderr, "kernel_launch: launch %d failed\n", li); break; }
    }
}
```
